# Optimizing an MI355X kernel written in HIP

```python
import jax, jax.numpy as jnp
from jax import lax
import numpy as np

D_MODEL = 2048
BATCH = 8
SEQ = 2048
DEPTH = 1

N_META = 16
CONV_K = 4
EPS = 1e-6
SSD_D_INNER = D_MODEL
SSD_HEAD_DIM = 64
SSD_HEADS = SSD_D_INNER // SSD_HEAD_DIM
SSD_GROUPS = 8
SSD_HPG = SSD_HEADS // SSD_GROUPS
SSD_STATE = 128
SSD_CHUNK = 128
SSD_CONV_DIM = SSD_D_INNER + 2 * SSD_GROUPS * SSD_STATE
LRU_WIDTH = D_MODEL
LRU_HEADS = 8
LRU_BLOCK = LRU_WIDTH // LRU_HEADS
LRU_C = 8.0
N_BRANCH = 2
COL_Z = SSD_D_INNER
COL_XBC = COL_Z + SSD_CONV_DIM
COL_DT = COL_XBC + SSD_HEADS
COL_LX = COL_DT + LRU_WIDTH
COL_LY = COL_LX + LRU_WIDTH
IN_COLS = COL_LY + N_BRANCH * D_MODEL
MOE_GROUPS = 8
MOE_EXP_PER_GROUP = 8
MOE_EXPERTS = MOE_GROUPS * MOE_EXP_PER_GROUP
MOE_TOPK = 2
MOE_FF = D_MODEL // 2
MOE_BLOCK = 128

kernel_name = "hybrid_ssd_rglru_hmoe_block"


def _rmsnorm(x, g):
    xf = x.astype(jnp.float32)
    y = xf * lax.rsqrt(jnp.mean(xf * xf, axis=-1, keepdims=True) + EPS)
    return (y * g.astype(jnp.float32)).astype(x.dtype)


def _causal_dwconv(x, w, b):
    k = w.shape[0]
    l = x.shape[1]
    xp = jnp.pad(x, ((0, 0), (k - 1, 0), (0, 0)))
    out = b
    for i in range(k):
        out = out + xp[:, i:i + l] * w[i]
    return out


def _ssd_branch(z, xbc, dt_raw, conv_w, conv_b, dt_bias, a_log, d_skip, norm_w):
    b, l, _ = xbc.shape
    xbc = jax.nn.silu(_causal_dwconv(xbc, conv_w, conv_b))
    xs, bm, cm = jnp.split(xbc, [SSD_D_INNER, SSD_D_INNER + SSD_GROUPS * SSD_STATE], axis=-1)
    xs = xs.reshape(b, l, SSD_HEADS, SSD_HEAD_DIM)
    dt = jax.nn.softplus((dt_raw + dt_bias).astype(jnp.float32))
    a = -jnp.exp(a_log.astype(jnp.float32))
    pad = (-l) % SSD_CHUNK
    lp = l + pad
    nc = lp // SSD_CHUNK
    q = SSD_CHUNK

    def front(t):
        return jnp.pad(t, ((0, 0), (pad, 0)) + ((0, 0),) * (t.ndim - 2))

    xdt = front(xs * dt[..., None]).reshape(b, nc, q, SSD_GROUPS, SSD_HPG, SSD_HEAD_DIM)
    bmc = front(bm).reshape(b, nc, q, SSD_GROUPS, SSD_STATE)
    cmc = front(cm).reshape(b, nc, q, SSD_GROUPS, SSD_STATE)
    a_dt = jnp.moveaxis(front(dt * a).reshape(b, nc, q, SSD_GROUPS, SSD_HPG), 2, -1)
    a_cum = jnp.cumsum(a_dt, axis=-1)
    causal = jnp.tril(jnp.ones((q, q), dtype=bool))
    seg = jnp.where(causal, a_cum[..., :, None] - a_cum[..., None, :], -jnp.inf)
    decay_in = jnp.exp(seg)
    cb = jnp.einsum('bclgn,bcsgn->bcgls', cmc, bmc)
    y_diag = jnp.einsum('bcgls,bcgjls,bcsgjp->bclgjp', cb, decay_in, xdt)
    decay_to_end = jnp.exp(a_cum[..., -1:] - a_cum)
    states = jnp.einsum('bcsgn,bcgjs,bcsgjp->bcgjpn', bmc, decay_to_end, xdt)
    chunk_decay = jnp.exp(a_cum[..., -1])

    def step(carry, inp):
        st, dec = inp
        return carry * dec[..., None, None] + st, carry

    _, prev = lax.scan(step, jnp.zeros_like(states[:, 0]),
                       (jnp.moveaxis(states, 1, 0), jnp.moveaxis(chunk_decay, 1, 0)))
    prev = jnp.moveaxis(prev, 0, 1)
    y_off = jnp.einsum('bclgn,bcgjpn,bcgjl->bclgjp', cmc, prev, jnp.exp(a_cum))
    y = (y_diag + y_off).reshape(b, lp, SSD_HEADS, SSD_HEAD_DIM)[:, pad:]
    y = y + d_skip[:, None] * xs
    y = y.reshape(b, l, SSD_D_INNER) * jax.nn.silu(z)
    yg = y.reshape(b, l, SSD_GROUPS, SSD_D_INNER // SSD_GROUPS).astype(jnp.float32)
    yg = yg * lax.rsqrt(jnp.mean(yg * yg, axis=-1, keepdims=True) + EPS)
    return (yg.reshape(b, l, SSD_D_INNER) * norm_w).astype(z.dtype)


def _rglru_branch(xb, yb, conv_w, conv_b, wa, ba, wx, bx, lam):
    b, l, _ = xb.shape
    xr = _causal_dwconv(xb, conv_w, conv_b)
    xh = xr.reshape(b, l, LRU_HEADS, LRU_BLOCK)
    gate_r = jax.nn.sigmoid((jnp.einsum('blhi,hij->blhj', xh, wa).reshape(b, l, LRU_WIDTH) + ba).astype(jnp.float32))
    gate_i = jax.nn.sigmoid((jnp.einsum('blhi,hij->blhj', xh, wx).reshape(b, l, LRU_WIDTH) + bx).astype(jnp.float32))
    log_a = -LRU_C * gate_r * jax.nn.softplus(-lam.astype(jnp.float32))
    a = jnp.exp(log_a)
    mult = jnp.sqrt(-jnp.expm1(2.0 * log_a))
    u = mult * gate_i * xr.astype(jnp.float32)

    def combine(left, right):
        a_l, u_l = left
        a_r, u_r = right
        return a_l * a_r, a_r * u_l + u_r

    _, h = lax.associative_scan(combine, (a, u), axis=1)
    return (h * jax.nn.gelu(yb.astype(jnp.float32))).astype(xb.dtype)


def _moe(u, w_rg, w_re, w1, w3, w2):
    b, l, d = u.shape
    t = u.reshape(b * l, d)
    n_tok = t.shape[0]
    g_prob = jax.nn.softmax((t @ w_rg).astype(jnp.float32), axis=-1)
    g_p, g_idx = lax.top_k(g_prob, 1)
    e_logits = (t @ w_re).reshape(n_tok, MOE_GROUPS, MOE_EXP_PER_GROUP)
    e_sel = jnp.take_along_axis(e_logits, g_idx[:, :, None], axis=1)[:, 0]
    e_prob = jax.nn.softmax(e_sel.astype(jnp.float32), axis=-1)
    e_p, e_loc = lax.top_k(e_prob, MOE_TOPK)
    gates = g_p * e_p / jnp.sum(e_p, axis=-1, keepdims=True)
    expert_id = g_idx * MOE_EXP_PER_GROUP + e_loc

    n_asg = n_tok * MOE_TOPK
    n_blocks = -(-(n_asg + MOE_EXPERTS * (MOE_BLOCK - 1)) // MOE_BLOCK)
    p_len = n_blocks * MOE_BLOCK
    flat_e = expert_id.reshape(-1)
    flat_tok = jnp.repeat(jnp.arange(n_tok, dtype=jnp.int32), MOE_TOPK)
    flat_gate = gates.reshape(-1)
    order = jnp.argsort(flat_e)
    se = flat_e[order]
    counts = jnp.bincount(flat_e, length=MOE_EXPERTS)
    padded = (counts + MOE_BLOCK - 1) // MOE_BLOCK * MOE_BLOCK
    pad_end = jnp.cumsum(padded)
    pad_start = pad_end - padded
    start = jnp.cumsum(counts) - counts
    dest = pad_start[se] + jnp.arange(n_asg) - start[se]
    buf_tok = jnp.full((p_len,), n_tok, dtype=jnp.int32).at[dest].set(flat_tok[order])
    buf_gate = jnp.zeros((p_len,), u.dtype).at[dest].set(flat_gate[order].astype(u.dtype))
    blk_e = jnp.minimum(jnp.searchsorted(pad_end, jnp.arange(n_blocks) * MOE_BLOCK, side='right'),
                        MOE_EXPERTS - 1)
    t_pad = jnp.concatenate([t, jnp.zeros((1, d), t.dtype)], axis=0)

    def expert_block(args):
        tok, gate, e = args
        xb = t_pad[tok]
        hdn = jax.nn.silu(xb @ w1[e]) * (xb @ w3[e])
        return (hdn @ w2[e]) * gate[:, None]

    y_blocks = lax.map(expert_block, (buf_tok.reshape(n_blocks, MOE_BLOCK),
                                      buf_gate.reshape(n_blocks, MOE_BLOCK), blk_e))
    out = jnp.zeros((n_tok + 1, d), u.dtype).at[buf_tok].add(y_blocks.reshape(p_len, d).astype(u.dtype))
    return out[:n_tok].reshape(b, l, d)


def setup_inputs(seed: int = 0) -> dict:
    key = jax.random.key(seed)
    ks = jax.random.split(key, 32)
    f32 = jnp.float32

    def nrm(k, shape, scale):
        return jax.random.normal(k, shape, f32) * scale

    dt0 = jnp.exp(jax.random.uniform(ks[6], (DEPTH, SSD_HEADS), f32, np.log(1e-3), np.log(1e-1)))
    a_pow = jax.random.uniform(ks[14], (DEPTH, LRU_WIDTH), f32, 0.9, 0.999)
    a_base = a_pow ** (1.0 / LRU_C)
    return {
        "x": nrm(ks[0], (BATCH, SEQ, D_MODEL), 1.0),
        "meta_tokens": nrm(ks[1], (N_META, D_MODEL), 1.0),
        "norm_mix": 1.0 + nrm(ks[2], (DEPTH, D_MODEL), 0.02),
        "w_in": nrm(ks[3], (DEPTH, D_MODEL, IN_COLS), D_MODEL ** -0.5),
        "ssd_conv_w": nrm(ks[4], (DEPTH, CONV_K, SSD_CONV_DIM), CONV_K ** -0.5),
        "ssd_conv_b": nrm(ks[5], (DEPTH, SSD_CONV_DIM), 0.01),
        "ssd_dt_bias": dt0 + jnp.log(-jnp.expm1(-dt0)),
        "ssd_a_log": jnp.log(jax.random.uniform(ks[7], (DEPTH, SSD_HEADS), f32, 1.0, 16.0)),
        "ssd_d": 1.0 + nrm(ks[8], (DEPTH, SSD_HEADS), 0.02),
        "ssd_norm": 1.0 + nrm(ks[9], (DEPTH, SSD_D_INNER), 0.02),
        "w_ssd_out": nrm(ks[10], (DEPTH, SSD_D_INNER, D_MODEL), SSD_D_INNER ** -0.5),
        "lru_conv_w": nrm(ks[11], (DEPTH, CONV_K, LRU_WIDTH), CONV_K ** -0.5),
        "lru_conv_b": nrm(ks[12], (DEPTH, LRU_WIDTH), 0.01),
        "lru_wa": nrm(ks[13], (DEPTH, LRU_HEADS, LRU_BLOCK, LRU_BLOCK), LRU_BLOCK ** -0.5),
        "lru_ba": nrm(ks[15], (DEPTH, LRU_WIDTH), 0.01),
        "lru_wx": nrm(ks[16], (DEPTH, LRU_HEADS, LRU_BLOCK, LRU_BLOCK), LRU_BLOCK ** -0.5),
        "lru_bx": nrm(ks[17], (DEPTH, LRU_WIDTH), 0.01),
        "lru_lambda": jnp.log(a_base) - jnp.log1p(-a_base),
        "w_lru_out": nrm(ks[18], (DEPTH, LRU_WIDTH, D_MODEL), LRU_WIDTH ** -0.5),
        "gate_bias": nrm(ks[19], (DEPTH, N_BRANCH, D_MODEL), 0.01),
        "w_out": nrm(ks[20], (DEPTH, D_MODEL, D_MODEL), D_MODEL ** -0.5),
        "norm_ffn": 1.0 + nrm(ks[21], (DEPTH, D_MODEL), 0.02),
        "w_router_group": nrm(ks[22], (DEPTH, D_MODEL, MOE_GROUPS), D_MODEL ** -0.5),
        "w_router_expert": nrm(ks[23], (DEPTH, D_MODEL, MOE_EXPERTS), D_MODEL ** -0.5),
        "w_exp_gate": nrm(ks[24], (DEPTH, MOE_EXPERTS, D_MODEL, MOE_FF), D_MODEL ** -0.5),
        "w_exp_up": nrm(ks[25], (DEPTH, MOE_EXPERTS, D_MODEL, MOE_FF), D_MODEL ** -0.5),
        "w_exp_down": nrm(ks[26], (DEPTH, MOE_EXPERTS, MOE_FF, D_MODEL), MOE_FF ** -0.5),
        "norm_final": 1.0 + nrm(ks[27], (D_MODEL,), 0.02),
    }


def reference(x, meta_tokens, norm_mix, w_in, ssd_conv_w, ssd_conv_b, ssd_dt_bias, ssd_a_log,
              ssd_d, ssd_norm, w_ssd_out, lru_conv_w, lru_conv_b, lru_wa, lru_ba, lru_wx, lru_bx,
              lru_lambda, w_lru_out, gate_bias, w_out, norm_ffn, w_router_group, w_router_expert,
              w_exp_gate, w_exp_up, w_exp_down, norm_final):
    b = x.shape[0]
    meta = jnp.broadcast_to(meta_tokens.astype(x.dtype)[None], (b, N_META, D_MODEL))
    h = jnp.concatenate([meta, x], axis=1)
    l = h.shape[1]
    for layer in range(DEPTH):
        u = _rmsnorm(h, norm_mix[layer])
        proj = u @ w_in[layer]
        z, xbc, dt_raw, lx, ly, gl = jnp.split(proj, [COL_Z, COL_XBC, COL_DT, COL_LX, COL_LY], axis=-1)
        y_ssd = _ssd_branch(z, xbc, dt_raw, ssd_conv_w[layer], ssd_conv_b[layer], ssd_dt_bias[layer],
                            ssd_a_log[layer], ssd_d[layer], ssd_norm[layer]) @ w_ssd_out[layer]
        y_lru = _rglru_branch(lx, ly, lru_conv_w[layer], lru_conv_b[layer], lru_wa[layer], lru_ba[layer],
                              lru_wx[layer], lru_bx[layer], lru_lambda[layer]) @ w_lru_out[layer]
        gates = jax.nn.sigmoid((gl.reshape(b, l, N_BRANCH, D_MODEL) + gate_bias[layer]).astype(jnp.float32)).astype(h.dtype)
        mixed = gates[..., 0, :] * y_ssd + gates[..., 1, :] * y_lru
        h = h + mixed @ w_out[layer]
        h = h + _moe(_rmsnorm(h, norm_ffn[layer]), w_router_group[layer], w_router_expert[layer],
                     w_exp_gate[layer], w_exp_up[layer], w_exp_down[layer])
    return _rmsnorm(h, norm_final)[:, N_META:]
```

```cpp
#include <hip/hip_runtime.h>
#include <stdint.h>
#include <string.h>
#include <stdio.h>

#ifndef MK_N_LAUNCHES
#define MK_N_LAUNCHES 1
#endif

#define LAS __attribute__((address_space(3)))
typedef unsigned short bf16_t;
typedef short bf16x8 __attribute__((ext_vector_type(8)));
typedef float f32x4 __attribute__((ext_vector_type(4)));
typedef float f32x2 __attribute__((ext_vector_type(2)));
typedef float f32x16 __attribute__((ext_vector_type(16)));
typedef unsigned u32x4 __attribute__((ext_vector_type(4)));
typedef unsigned u32x2 __attribute__((ext_vector_type(2)));

constexpr int D = 2048, NBATCH = 8, SEQ = 2048, NMETA = 16;
constexpr int T = NBATCH * SEQ;
constexpr int TR = T + NMETA;
constexpr int TRP = 65 * 256;
constexpr int NP = 14336;
constexpr int OZ = 0, OXBC = 2048, OLX = 6144, OLY = 8192, OGL = 10240;
constexpr int NHEAD = 32, HD = 64, NGRP = 8, NST = 128;
constexpr int NEXP = 64, FF = 1024;
constexpr float EPS = 1e-6f;
constexpr int NTHREADS = 512;

constexpr size_t MiB = 1024 * 1024;
constexpr size_t WS_CTL = 0;
constexpr size_t CTL_BYTES = 64 * 1024;
constexpr size_t CW_BAR = 0;
constexpr size_t CW_CNT = 4096;
constexpr size_t WS_LIST = 1 * MiB;
constexpr size_t WS_GATE = WS_LIST + 4 * MiB;
constexpr size_t WS_RSTD = WS_GATE + 128 * 1024;
constexpr size_t WS_WRH = WS_GATE + 256 * 1024;
constexpr size_t WS_WRL = WS_GATE + 640 * 1024;
constexpr size_t WS_DT = WS_GATE + 1 * MiB;
constexpr size_t WS_WIN = WS_DT + 3 * MiB;
constexpr size_t WS_WSO = WS_WIN + 57 * MiB;
constexpr size_t WS_WLO = WS_WSO + 8 * MiB;
constexpr size_t WS_WOUT = WS_WLO + 8 * MiB;
constexpr size_t WS_WLRU = WS_WOUT + 8 * MiB;
constexpr size_t WS_W13 = WS_WLRU + 2 * MiB;
constexpr size_t WS_W2 = WS_W13 + 512 * MiB;
constexpr size_t WS_U = WS_W2 + 256 * MiB;
constexpr size_t WS_XR = WS_U + 65 * MiB;
constexpr size_t WS_LOGA = WS_XR + 65 * MiB;
constexpr size_t WS_LU = WS_LOGA + 65 * MiB;
constexpr size_t WS_YSSD = WS_LU + 65 * MiB;
constexpr size_t WS_YSSDN = WS_YSSD + 64 * MiB;
constexpr size_t WS_YLRU = WS_YSSDN + 64 * MiB;
constexpr size_t WS_PROJ = WS_YLRU + 64 * MiB;
constexpr size_t WS_XBCS = WS_PROJ + 455 * MiB;
constexpr size_t WS_END = WS_XBCS + 130 * MiB;
constexpr size_t WS_T1 = WS_U;
constexpr size_t WS_MIXED = WS_LOGA;
constexpr size_t WS_H1 = WS_LU;
constexpr size_t WS_U2 = WS_YSSDN;
constexpr size_t WS_HDN = WS_PROJ;
constexpr size_t WS_Y = WS_PROJ + 96 * MiB;
static_assert(WS_END <= 2048 * MiB, "workspace");
static_assert((size_t)14368 * 2048 * 2 <= 57 * MiB && (size_t)TRP * 2048 * 2 <= 65 * MiB && (size_t)TRP * NP * 2 <= 455 * MiB, "sizes");

typedef __bf16 bf16x2_t __attribute__((ext_vector_type(2)));
__device__ __forceinline__ unsigned cvt_pk_bf16(float lo, float hi) { const f32x2 v = {lo, hi}; const bf16x2_t b = __builtin_convertvector(v, bf16x2_t); return __builtin_bit_cast(unsigned, b); }
__device__ __forceinline__ unsigned short f2bf(float v) { return (unsigned short)(cvt_pk_bf16(v, 0.f) & 0xffffu); }
__device__ __forceinline__ float bf2f(unsigned short b) { return __uint_as_float(((unsigned)b) << 16); }
__device__ __forceinline__ float bflo(unsigned w) { return __uint_as_float(w << 16); }
__device__ __forceinline__ float bfhi(unsigned w) { return __uint_as_float(w & 0xffff0000u); }
__device__ __forceinline__ float sigmoidf_(float x) { return __builtin_amdgcn_rcpf(1.0f + __expf(-x)); }
__device__ __forceinline__ float siluf_(float x) { return x * __builtin_amdgcn_rcpf(1.0f + __expf(-x)); }
__device__ __forceinline__ float gelu_tanh_(float x) { const float y = 1.5957691216f * (x + 0.044715f * x * x * x); return x * __builtin_amdgcn_rcpf(1.0f + __expf(-y)); }
__device__ __forceinline__ float softplusf_(float x) { return fmaxf(x, 0.0f) + __logf(1.0f + __expf(-fabsf(x))); }
__device__ __forceinline__ float wave_sum(float v) {
#pragma unroll
    for (int o = 32; o > 0; o >>= 1) v += __shfl_xor(v, o);
    return v;
}

#define XB_TMO      128
#define XB_XCNT(j)  (256  + 64 * (j))
#define XB_XSUB(j)  (1280 + 64 * (j))
#define XB_XGEN(j)  (2304 + 64 * (j))
#define XB_TOP      3328
#define XB_TOPGEN   3392
#define XCD_BAR_WORDS 3456
#define XB_SPIN_CAP (1u << 22)

__device__ __forceinline__ unsigned xb_ld(unsigned* p)              { return __hip_atomic_load(p, __ATOMIC_RELAXED, __HIP_MEMORY_SCOPE_AGENT); }
__device__ __forceinline__ unsigned xb_add(unsigned* p, unsigned v) { return __hip_atomic_fetch_add(p, v, __ATOMIC_RELAXED, __HIP_MEMORY_SCOPE_AGENT); }
__device__ __forceinline__ unsigned xb_xcc_id() { return (unsigned)__builtin_amdgcn_s_getreg((3 << 11) | 20) & 0xFu; }
#define XB_SPIN(cond, bar) do { unsigned _sp = 0; while (cond) { __builtin_amdgcn_s_sleep(1); \
    if ((++_sp & 255u) == 0u) { if (xb_ld(&(bar)[XB_TMO])) break; if (_sp > XB_SPIN_CAP) { atomicAdd(&(bar)[XB_TMO], 1u); break; } } } } while (0)

struct XcdBarrier { unsigned* bar; unsigned x; volatile LAS unsigned* st; };

__device__ __forceinline__ XcdBarrier xcd_barrier_post(unsigned* bar, volatile LAS unsigned* st) {
    XcdBarrier b; b.bar = bar; b.x = xb_xcc_id(); b.st = st;
    if (threadIdx.x == 0) (void)xb_add(&bar[XB_XCNT(b.x)], 1u);
    return b;
}
__device__ __forceinline__ void xcd_barrier_complete(unsigned* bar, unsigned x, unsigned& nloc, unsigned& nx) {
    const unsigned G = gridDim.x * gridDim.y * gridDim.z;
    unsigned sum, cnt, mine, sp = 0u;
    for (;;) {
        sum = 0u; cnt = 0u; mine = 0u;
#pragma unroll
        for (unsigned j = 0; j < 16; ++j) { const unsigned c = xb_ld(&bar[XB_XCNT(j)]); sum += c; cnt += (c > 0u) ? 1u : 0u; mine = (j == x) ? c : mine; }
        if (sum == G) break;
        __builtin_amdgcn_s_sleep(1);
        if ((++sp & 255u) == 0u) { if (xb_ld(&bar[XB_TMO])) break; if (sp > XB_SPIN_CAP) { atomicAdd(&bar[XB_TMO], 1u); break; } }
    }
    nloc = mine > 0u ? mine : 1u; nx = cnt > 0u ? cnt : 1u;
}
__device__ __forceinline__ void xcd_barrier(const XcdBarrier& b) {
    asm volatile("s_waitcnt vmcnt(0)" ::: "memory");
    __syncthreads();
    if (threadIdx.x == 0) {
        unsigned* bar = b.bar;
        __builtin_amdgcn_s_waitcnt(0);
        unsigned nloc = b.st[0], nx = b.st[1];
        if (nloc == 0u) { xcd_barrier_complete(bar, b.x, nloc, nx); b.st[0] = nloc; b.st[1] = nx; }
        const unsigned old = xb_add(&bar[XB_XSUB(b.x)], 1u);
        const unsigned gen = old / nloc;
        if (old + 1u == (gen + 1u) * nloc) {
            __builtin_amdgcn_fence(__ATOMIC_RELEASE, "agent");
            asm volatile("s_waitcnt vmcnt(0)" ::: "memory");
            const unsigned og = xb_add(&bar[XB_TOP], 1u);
            const unsigned tg = og / nx;
            if (og + 1u == (tg + 1u) * nx) xb_add(&bar[XB_TOPGEN], 1u);
            else XB_SPIN(xb_ld(&bar[XB_TOPGEN]) == tg, bar);
            __builtin_amdgcn_fence(__ATOMIC_ACQUIRE, "agent");
            xb_add(&bar[XB_XGEN(b.x)], 1u);
            asm volatile("s_waitcnt vmcnt(0)" ::: "memory");
        } else {
            XB_SPIN(xb_ld(&bar[XB_XGEN(b.x)]) == gen, bar);
            __builtin_amdgcn_fence(__ATOMIC_ACQUIRE, "agent");
            asm volatile("s_waitcnt vmcnt(0)" ::: "memory");
        }
    }
    __syncthreads();
}

namespace pg8 {
constexpr int BM = 256, BK = 64, HALF = 128, HTB = HALF * BK * 2, STAGE_BYTES = 8 * HTB, NXCD = 8, WGM = 8;
__host__ __device__ __forceinline__ int lds_byte(int r, int c) { const int st = (r >> 4) * 2 + (c >> 5), rr = r & 15, cc = c & 31, ob = rr * 64 + cc * 2; return st * 1024 + (ob ^ (((ob >> 9) & 1) << 5)); }
__host__ __device__ __forceinline__ void stage_rc(int b, int& R, int& C) { const int st = b >> 10, sb = b & 1023, swz = sb ^ (((sb >> 9) & 1) << 5); R = (st >> 1) * 16 + (swz >> 6); C = (st & 1) * 32 + ((swz & 63) >> 1); }
__host__ __device__ __forceinline__ int perm32(int rho) { const int n = rho >> 4, i = rho & 15; return 8 * (i >> 2) + 4 * n + (i & 3); }

struct Unit { const char* A; const char* B; const char* B1; int pm, pn, e, cnt, par; };

struct DenseSched {
    static constexpr int ldb = 0;
    const char* A; const char* B; int lda  , K, nM, nN, nwg, G, c, acb  ;
    __device__ void init(const void* A_, int lda_bytes, const void* B_, int K_, int nM_, int nN_, int G_, int c_, int acb_ = 0) { A = (const char*)A_; B = (const char*)B_; lda = lda_bytes; K = K_; nM = nM_; nN = nN_; nwg = nM * nN; G = G_; c = c_; acb = acb_; }
    __device__ bool next(int i, Unit& u) const {
        const long L = (long)i * G + c; if (L >= nwg) return false;
        int wgid = (int)L; { const int q = nwg / NXCD, r = nwg % NXCD, xcd = wgid % NXCD, off = wgid / NXCD; wgid = (xcd < r ? xcd * (q + 1) : r * (q + 1) + (xcd - r) * q) + off; }
        const int nig = WGM * nN, gid = wgid / nig, fm = gid * WGM, gsz = (nM - fm) < WGM ? (nM - fm) : WGM;
        u.pm = fm + ((wgid % nig) % gsz); u.pn = (wgid % nig) / gsz; u.e = 0; u.cnt = 256; u.par = 0;
        u.A = A + (size_t)u.pm * 256 * lda + (size_t)(u.pn >> 1) * acb; u.B = B + (size_t)u.pn * 256 * K * 2; u.B1 = u.B;
        return true;
    }
    __device__ __forceinline__ void aoffs(const Unit&, const int (&R)[2], const int (&C)[2], unsigned (&v)[4]) const {
#pragma unroll
        for (int h = 0; h < 2; ++h)
#pragma unroll
            for (int i = 0; i < 2; ++i) v[h * 2 + i] = (unsigned)((R[i] + 128 * h) * lda + C[i] * 2);
    }
};

struct PairSched {
    static constexpr int ldb = 0;
    const char* A0; const char* A1; const char* B0; const char* B1; int lda, K, nM, nN, nwg, G, c;
    __device__ void init(const void* A0_, const void* A1_, int lda_bytes, const void* B0_, const void* B1_, int K_, int nM_, int nN_, int G_, int c_) {
        A0 = (const char*)A0_; A1 = (const char*)A1_; B0 = (const char*)B0_; B1 = (const char*)B1_; lda = lda_bytes; K = K_; nM = nM_; nN = nN_; nwg = nM * nN; G = G_; c = c_; }
    __device__ bool next(int i, Unit& u) const {
        const long L = (long)(i >> 1) * G + c; if (L >= nwg) return false;
        int wgid = (int)L; { const int q = nwg / NXCD, r = nwg % NXCD, xcd = wgid % NXCD, off = wgid / NXCD; wgid = (xcd < r ? xcd * (q + 1) : r * (q + 1) + (xcd - r) * q) + off; }
        const int nig = WGM * nN, gid = wgid / nig, fm = gid * WGM, gsz = (nM - fm) < WGM ? (nM - fm) : WGM;
        u.pm = fm + ((wgid % nig) % gsz); u.pn = (wgid % nig) / gsz; u.e = i & 1; u.cnt = 256; u.par = 0;
        u.A = ((i & 1) ? A1 : A0) + (size_t)u.pm * 256 * lda; u.B = ((i & 1) ? B1 : B0) + (size_t)u.pn * 256 * K * 2; u.B1 = u.B;
        return true;
    }
    __device__ __forceinline__ void aoffs(const Unit&, const int (&R)[2], const int (&C)[2], unsigned (&v)[4]) const {
#pragma unroll
        for (int h = 0; h < 2; ++h)
#pragma unroll
            for (int i = 0; i < 2; ++i) v[h * 2 + i] = (unsigned)((R[i] + 128 * h) * lda + C[i] * 2);
    }
};

struct MoeSched {
    const char* A; const char* W0; const char* W1; const int* list; const float* rowval; LAS const int* ub; LAS const int* us; LAS const int* tb; LAS const int* cl; LAS unsigned char* rowtbl;
    int lda, K, nN, G, c, gather, ldb  , cpn  , valshift  ; size_t bstride  ;
    __device__ bool next(int i, Unit& u) const {
        int p = (G & 7) == 0 ? (c & 7) * (G >> 3) + (c >> 3) : c; if (i & 1) p = G - 1 - p;
        const int L = i * G + p, totL = ub[NEXP]; if (L >= totL + us[NEXP]) return false;
        const bool sh = L >= totL; const LAS int* pre = sh ? us : ub; const int Lq = sh ? L - totL : L;
        int lo = 0, hi = NEXP - 1;
        while (lo < hi) { const int mid = (lo + hi + 1) >> 1; if (pre[mid] <= Lq) lo = mid; else hi = mid - 1; }
        const int e = lo, r = Lq - pre[e], mt = tb[e + 1] - tb[e], nl = mt - (us[e + 1] != us[e] ? 1 : 0);
        u.e = e; u.pn = sh ? r : r / nl; const int m = sh ? mt - 1 : r % nl; u.pm = tb[e] + m; u.par = i & 1;
        const int ce = cl[e]; u.cnt = (ce - m * 256) < 256 ? (ce - m * 256) : 256;
        u.B = W0 + (size_t)e * bstride + (size_t)u.pn * cpn; u.B1 = W1 + (size_t)e * bstride + (size_t)u.pn * cpn;
        u.A = gather ? A : A + (size_t)u.pm * 256 * lda;
        return true;
    }
    __device__ __forceinline__ const int* entry_ptr(const Unit& u, int t) const { return list + (size_t)u.e * T + (u.pm - tb[u.e]) * 256 + (t < u.cnt ? t : 0); }
    __device__ __forceinline__ const float* val_ptr(int entry) const { return rowval + (entry >> valshift); }
    __device__ __forceinline__ LAS int* tbl_ent(int par) const { return (LAS int*)(rowtbl + par * 2048); }
    __device__ __forceinline__ LAS float* tbl_val(int par) const { return (LAS float*)(rowtbl + par * 2048 + 1024); }
    __device__ __forceinline__ void aoffs(const Unit& u, const int (&R)[2], const int (&C)[2], unsigned (&v)[4]) const {
        const LAS int* te = tbl_ent(u.par);
#pragma unroll
        for (int h = 0; h < 2; ++h)
#pragma unroll
            for (int i = 0; i < 2; ++i) {
                const int r = R[i] + 128 * h;
                if (gather) v[h * 2 + i] = (unsigned)(te[r] >> 1) * (unsigned)lda + (unsigned)(C[i] * 2);
                else v[h * 2 + i] = (unsigned)(r * lda + C[i] * 2);
            }
    }
};

template <class Epi, class Sched, bool DYN, bool BF32 = false, bool PAIR = false, bool MSKIP = false, bool TBL = false>
__device__ __forceinline__ void gemm_phase(LAS unsigned char* lds, const int K, const Sched& S, const Epi& E) {
    const int tid = threadIdx.x, wid = __builtin_amdgcn_readfirstlane(tid >> 6), lane = tid & 63, wr = wid >> 2, wc = wid & 3, fr = lane & 15, fq = lane >> 4;
    const int nt = K / BK;
    int Rr[2], Cc[2]; unsigned voffB[2];
#pragma unroll
    for (int i = 0; i < 2; ++i) { stage_rc(tid * 16 + i * 8192, Rr[i], Cc[i]); const int Rb = Epi::PERM ? ((Rr[i] & ~31) + perm32(Rr[i] & 31)) : Rr[i]; voffB[i] = (unsigned)(Rb * K + Cc[i]) * 2u; }
    const size_t kstep = (size_t)(BK * 2);
    const size_t hstepB = (size_t)HALF * K * 2;
    const unsigned ldsw = (unsigned)wid * 1024u;
    const int aoff = lds_byte(wr * 64 + fr, fq * 8), boff = lds_byte(wc * 32 + fr, fq * 8);
    const int ldb = S.ldb;
    const size_t kstepW = (size_t)BK * (size_t)ldb;
    unsigned wgo = 0, wlo = 0;
    if (BF32) {
        static_assert(!BF32 || Epi::PERM, "the f32-weight staging assumes the permuted row slots");
        const int kq = 8 * (wid >> 2) + (lane >> 3), ng = 8 * (wid & 3) + (lane & 7);
        wgo = (unsigned)(4 * kq) * (unsigned)ldb + (unsigned)(16 * ng);
        const int c0 = 4 * ng;
        const int rho0 = Epi::PERM ? (16 * ((c0 >> 2) & 1) + 4 * ((c0 & 31) >> 3)) : (c0 & 31);
        wlo = (unsigned)lds_byte((c0 & ~31) + rho0, 4 * kq);
    }
    f32x4 wr0[4], wr1[4];
#define PG8_WISSUE(set, gbase) do { _Pragma("unroll") for (int _i = 0; _i < 4; ++_i) { const char* _p = (const char*)(gbase) + (size_t)_i * ldb; \
        asm volatile("global_load_dwordx4 %0, %1, %2" : "=v"(set[_i]) : "v"(wgo), "s"(_p) : "memory"); } } while (0)
#define PG8_WWAIT(set, n) asm volatile("s_waitcnt vmcnt(" #n ")" : "+v"(set[0]), "+v"(set[1]), "+v"(set[2]), "+v"(set[3]) :: "memory")
#define PG8_WCOMMIT(set, bufoff) do { _Pragma("unroll") for (int _j = 0; _j < 4; ++_j) { u32x2 _w; _w.x = cvt_pk_bf16(set[0][_j], set[1][_j]); _w.y = cvt_pk_bf16(set[2][_j], set[3][_j]); \
        *(LAS u32x2*)(lds + (bufoff) + wlo + 64 * _j) = _w; } } while (0)
#define PG8_SA(b, h) (((b) * 2 + (h)) * HTB)
#define PG8_SB(b, h) ((4 + (b) * 2 + (h)) * HTB)
#define PG8_STAGE2(bufoff, gbase, o0, o1) do { \
        __builtin_amdgcn_global_load_lds((const unsigned*)((const char*)(gbase) + (o0)), (LAS unsigned*)(lds + (bufoff) + ldsw), 16, 0, 0); \
        __builtin_amdgcn_global_load_lds((const unsigned*)((const char*)(gbase) + (o1)), (LAS unsigned*)(lds + (bufoff) + ldsw + 8192), 16, 0, 0); } while (0)
#define PG8_STAGEB(bufoff, gbase) PG8_STAGE2(bufoff, gbase, voffB[0], voffB[1])
#define PG8_STAGEA(bufoff, gbase, v, h) PG8_STAGE2(bufoff, gbase, (v)[(h) * 2], (v)[(h) * 2 + 1])
#define PG8_TREAD(par, h, e0, e1) do { int _tz = threadIdx.x; asm volatile("" : "+v"(_tz)); int _r0, _c0, _r1, _c1; stage_rc(_tz * 16, _r0, _c0); stage_rc(_tz * 16 + 8192, _r1, _c1); \
        const LAS int* _te = S.tbl_ent(par); e0 = _te[_r0 + 128 * (h)]; e1 = _te[_r1 + 128 * (h)]; } while (0)
#define PG8_STAGEA_G(bufoff, gbase, e0, e1) do { int _tz = threadIdx.x; asm volatile("" : "+v"(_tz)); int _r0, _c0, _r1, _c1; stage_rc(_tz * 16, _r0, _c0); stage_rc(_tz * 16 + 8192, _r1, _c1); \
        PG8_STAGE2(bufoff, gbase, (unsigned)((e0) >> 1) * (unsigned)S.lda + (unsigned)(_c0 * 2), (unsigned)((e1) >> 1) * (unsigned)S.lda + (unsigned)(_c1 * 2)); } while (0)
#define PG8_LDA(dst, b, h) do { _Pragma("unroll") for (int m = 0; m < 4; ++m) _Pragma("unroll") for (int k = 0; k < 2; ++k) dst[m][k] = *(const LAS bf16x8*)(lds + PG8_SA(b, h) + aoff + m * 2048 + k * 1024); } while (0)
#define PG8_LDB(dst, b, h) do { _Pragma("unroll") for (int n = 0; n < 2; ++n) _Pragma("unroll") for (int k = 0; k < 2; ++k) dst[n][k] = *(const LAS bf16x8*)(lds + PG8_SB(b, h) + boff + n * 2048 + k * 1024); } while (0)
#define PG8_MMA(ai, bj, At, Bt) do { __builtin_amdgcn_s_setprio(1); _Pragma("unroll") for (int m = 0; m < 4; ++m) _Pragma("unroll") for (int n = 0; n < 2; ++n) _Pragma("unroll") for (int k = 0; k < 2; ++k) \
        acc[ai][bj][m][n] = __builtin_amdgcn_mfma_f32_16x16x32_bf16(Bt[n][k], At[m][k], acc[ai][bj][m][n], 0, 0, 0); __builtin_amdgcn_s_setprio(0); } while (0)
#define PG8_WAIT_V(n) asm volatile("s_waitcnt vmcnt(" #n ")" ::: "memory")
#define PG8_WAIT_L(n) asm volatile("s_waitcnt lgkmcnt(" #n ")" ::: "memory")
#define PG8_BAR __builtin_amdgcn_s_barrier()
#define PG8_SCHED __builtin_amdgcn_sched_barrier(0)
    Unit cur, nxt; int ui = 0;
    if (!S.next(0, cur)) return;
    f32x4 acc[2][2][4][2];
#pragma unroll
    for (int a = 0; a < 2; ++a)
#pragma unroll
        for (int b = 0; b < 2; ++b)
#pragma unroll
            for (int m = 0; m < 4; ++m)
#pragma unroll
                for (int n = 0; n < 2; ++n) acc[a][b][m][n] = (f32x4){0.f, 0.f, 0.f, 0.f};
    bf16x8 At[4][2], B0[2][2], B1[2][2];
    constexpr bool GT = TBL && DYN;
    unsigned vc[4], vn[4];
    int ge0 = 0, ge1 = 0;
    int tb_e = 0, tb_v = 0;
    if constexpr (BF32) { PG8_WISSUE(wr0, cur.B); PG8_WISSUE(wr1, cur.B1); }
    if constexpr (TBL) {
        if (tid < 256) { const int e0 = *S.entry_ptr(cur, tid); S.tbl_ent(cur.par)[tid] = e0; S.tbl_val(cur.par)[tid] = *S.val_ptr(e0); }
        PG8_WAIT_L(0); PG8_BAR;
    }
    if constexpr (!GT) {
        S.aoffs(cur, Rr, Cc, vc);
#pragma unroll
        for (int j = 0; j < 4; ++j) vn[j] = vc[j];
    }
    const char* cA = cur.A; const char* cB = cur.B; const char* cB1 = cur.B1;
    if (!BF32) {
        PG8_STAGEB(PG8_SB(0, 0), cB); PG8_STAGEA(PG8_SA(0, 0), cA, vc, 0); PG8_STAGEB(PG8_SB(0, 1), cB + hstepB); PG8_STAGEA(PG8_SA(0, 1), cA, vc, 1);
        if (wr == 1) PG8_BAR;
        PG8_WAIT_V(4); PG8_BAR;
        PG8_STAGEB(PG8_SB(1, 0), cB + kstep); PG8_STAGEA(PG8_SA(1, 0), cA + kstep, vc, 0); PG8_STAGEB(PG8_SB(1, 1), cB + hstepB + kstep);
        PG8_WAIT_V(6); PG8_BAR;
    } else {
        if constexpr (GT) { PG8_TREAD(cur.par, 0, ge0, ge1); PG8_STAGEA_G(PG8_SA(0, 0), cA, ge0, ge1); PG8_TREAD(cur.par, 1, ge0, ge1); PG8_STAGEA_G(PG8_SA(0, 1), cA, ge0, ge1); }
        else { PG8_STAGEA(PG8_SA(0, 0), cA, vc, 0); PG8_STAGEA(PG8_SA(0, 1), cA, vc, 1); }
        PG8_WWAIT(wr0, 8); PG8_WCOMMIT(wr0, PG8_SB(0, 0)); PG8_WWAIT(wr1, 4); PG8_WCOMMIT(wr1, PG8_SB(0, 1));
        PG8_WISSUE(wr0, cB + kstepW); PG8_WISSUE(wr1, cB1 + kstepW);
        if constexpr (GT) { PG8_TREAD(cur.par, 0, ge0, ge1); PG8_STAGEA_G(PG8_SA(1, 0), cA + kstep, ge0, ge1); } else PG8_STAGEA(PG8_SA(1, 0), cA + kstep, vc, 0);
        PG8_WWAIT(wr0, 6); PG8_WCOMMIT(wr0, PG8_SB(1, 0));
        PG8_WISSUE(wr0, cB + 2 * kstepW);
        if constexpr (GT) PG8_TREAD(cur.par, 1, ge0, ge1);
        if (wr == 1) PG8_BAR;
        PG8_WAIT_V(4); PG8_WAIT_L(0); PG8_BAR;
        PG8_BAR;
    }
    for (;;) {
        const bool has_next = S.next(ui + 1, nxt);
        const bool full = !MSKIP || cur.cnt > 128;
        if constexpr (TBL) { if (has_next && tid < 256) { const int* ep = S.entry_ptr(nxt, tid); asm volatile("global_load_dword %0, %1, off" : "=v"(tb_e) : "v"(ep) : "memory"); } }
        const char* nA = has_next ? nxt.A : cA; const char* nB = has_next ? nxt.B : cB; const char* nB1 = has_next ? nxt.B1 : cB1;
        for (int t = 0; t < nt; t += 2) {
            const bool last = (t == nt - 2);
            const char* a1 = cA + (size_t)(t + 1) * kstep;
            const char* a2 = last ? nA : cA + (size_t)(t + 2) * kstep; const char* b2 = last ? nB : cB + (size_t)(t + 2) * kstep;
            const char* a3 = a2 + kstep; const char* b3 = b2 + kstep;
            const char* w21 = last ? nB1 : cB1 + (size_t)(t + 2) * kstepW;
            const char* w30 = last ? nB + kstepW : cB + (size_t)(t + 3) * kstepW;
            const char* w31 = last ? nB1 + kstepW : cB1 + (size_t)(t + 3) * kstepW;
            const char* w40 = last ? nB + 2 * kstepW : (t + 4 < nt ? cB + (size_t)(t + 4) * kstepW : nB);
            if constexpr (TBL) {
                if (has_next && tid < 256) {
                    if (t == (nt >> 1)) {
                        asm volatile("s_waitcnt vmcnt(10)" : "+v"(tb_e) :: "memory");
                        S.tbl_ent(nxt.par)[tid] = tb_e;
                        const float* vp = S.val_ptr(tb_e); asm volatile("global_load_dword %0, %1, off" : "=v"(tb_v) : "v"(vp) : "memory");
                    }
                    if (last) {
                        asm volatile("s_waitcnt vmcnt(10)" : "+v"(tb_v) :: "memory");
                        S.tbl_ent(nxt.par)[256 + tid] = tb_v;
                    }
                }
            }
            const int npar = (last && has_next) ? nxt.par : cur.par;
            if constexpr (GT) { PG8_STAGEA_G(PG8_SA(1, 1), a1, ge0, ge1); PG8_SCHED; }
            PG8_LDB(B0, 0, 0); PG8_SCHED; PG8_LDA(At, 0, 0);
            if constexpr (!GT) PG8_STAGEA(PG8_SA(1, 1), a1, vc, 1);
            PG8_WAIT_L(8); PG8_BAR; PG8_WAIT_L(0); PG8_MMA(0, 0, At, B0); PG8_BAR; PG8_SCHED;
            if (DYN && !GT) { if (last && has_next) {
                int tz = threadIdx.x; asm volatile("" : "+v"(tz)); int R2[2], C2[2];
#pragma unroll
                for (int i = 0; i < 2; ++i) stage_rc(tz * 16 + i * 8192, R2[i], C2[i]);
                S.aoffs(nxt, R2, C2, vn); } }
            PG8_LDB(B1, 0, 1);
            if (BF32) { PG8_WWAIT(wr1, 8); PG8_WCOMMIT(wr1, PG8_SB(1, 1)); PG8_WISSUE(wr1, w21); } else PG8_STAGEB(PG8_SB(0, 0), b2);
            if constexpr (GT) PG8_TREAD(npar, 0, ge0, ge1);
            PG8_BAR; PG8_WAIT_L(0); PG8_MMA(0, 1, At, B1); PG8_BAR;
            if constexpr (GT) { PG8_STAGEA_G(PG8_SA(0, 0), a2, ge0, ge1); PG8_SCHED; }
            if (full) PG8_LDA(At, 0, 1);
            if constexpr (!GT) PG8_STAGEA(PG8_SA(0, 0), a2, vn, 0);
            PG8_BAR; PG8_WAIT_L(0); if (full) PG8_MMA(1, 0, At, B0); PG8_BAR; PG8_SCHED;
            if (BF32) { PG8_WWAIT(wr0, 8); PG8_WCOMMIT(wr0, PG8_SB(0, 0)); PG8_WISSUE(wr0, w30); PG8_WAIT_V(10); } else { PG8_STAGEB(PG8_SB(0, 1), b2 + hstepB); PG8_WAIT_V(6); }
            if constexpr (GT) { PG8_TREAD(npar, 1, ge0, ge1); PG8_WAIT_L(0); }
            PG8_BAR; if (full) PG8_MMA(1, 1, At, B1); PG8_BAR;
            if constexpr (GT) { PG8_STAGEA_G(PG8_SA(0, 1), a2, ge0, ge1); PG8_SCHED; }
            PG8_LDB(B0, 1, 0); PG8_SCHED; PG8_LDA(At, 1, 0);
            if constexpr (!GT) PG8_STAGEA(PG8_SA(0, 1), a2, vn, 1);
            PG8_WAIT_L(8); PG8_BAR; PG8_WAIT_L(0); PG8_MMA(0, 0, At, B0); PG8_BAR; PG8_SCHED;
            PG8_LDB(B1, 1, 1);
            if (BF32) { PG8_WWAIT(wr1, 8); PG8_WCOMMIT(wr1, PG8_SB(0, 1)); PG8_WISSUE(wr1, w31); } else PG8_STAGEB(PG8_SB(1, 0), b3);
            if constexpr (GT) PG8_TREAD(npar, 0, ge0, ge1);
            PG8_BAR; PG8_WAIT_L(0); PG8_MMA(0, 1, At, B1); PG8_BAR;
            if constexpr (GT) { PG8_STAGEA_G(PG8_SA(1, 0), a3, ge0, ge1); PG8_SCHED; }
            if (full) PG8_LDA(At, 1, 1);
            if constexpr (!GT) PG8_STAGEA(PG8_SA(1, 0), a3, vn, 0);
            PG8_BAR; PG8_WAIT_L(0); if (full) PG8_MMA(1, 0, At, B0); PG8_BAR; PG8_SCHED;
            if (BF32) { PG8_WWAIT(wr0, 8); PG8_WCOMMIT(wr0, PG8_SB(1, 0)); PG8_WISSUE(wr0, w40); PG8_WAIT_V(10); } else { PG8_STAGEB(PG8_SB(1, 1), b3 + hstepB); PG8_WAIT_V(6); }
            if constexpr (GT) { PG8_TREAD(npar, 1, ge0, ge1); PG8_WAIT_L(0); }
            PG8_BAR; if (full) PG8_MMA(1, 1, At, B1); PG8_BAR;
        }
        if constexpr (PAIR) {
            if (cur.e == 0) E.first(acc, cur, wr, wc, fr, fq); else E(acc, cur, wr, wc, fr, fq);
        } else E(acc, cur, wr, wc, fr, fq);
        if (!has_next) break;
        if (!(PAIR && cur.e == 0)) {
#pragma unroll
        for (int a = 0; a < 2; ++a)
#pragma unroll
            for (int b = 0; b < 2; ++b)
#pragma unroll
                for (int m = 0; m < 4; ++m)
#pragma unroll
                    for (int n = 0; n < 2; ++n) acc[a][b][m][n] = (f32x4){0.f, 0.f, 0.f, 0.f};
        }
        cur = nxt; cA = nA; cB = nB; cB1 = nB1; ++ui;
        if (DYN && !GT) {
#pragma unroll
            for (int j = 0; j < 4; ++j) vc[j] = vn[j];
        }
    }
    PG8_WAIT_V(0);
    if (BF32) { asm volatile("" :: "v"(wr0[0]), "v"(wr0[1]), "v"(wr0[2]), "v"(wr0[3]), "v"(wr1[0]), "v"(wr1[1]), "v"(wr1[2]), "v"(wr1[3])); }
    if (wr == 0) PG8_BAR;
    PG8_BAR;
#undef PG8_WISSUE
#undef PG8_WCOMMIT
#undef PG8_WWAIT
#undef PG8_SA
#undef PG8_SB
#undef PG8_STAGE2
#undef PG8_STAGEA
#undef PG8_TREAD
#undef PG8_STAGEA_G
#undef PG8_STAGEB
#undef PG8_LDA
#undef PG8_LDB
#undef PG8_MMA
#undef PG8_WAIT_V
#undef PG8_WAIT_L
#undef PG8_BAR
#undef PG8_SCHED
}
}

constexpr int LDS_STAGE = pg8::STAGE_BYTES;
constexpr int LDS_WORK = 144 * 1024;
constexpr int MISC_OFF = LDS_WORK;
constexpr int LDS_BYTES = LDS_WORK + 12288;
constexpr int MOE_ROWTBL_OFF = MISC_OFF + 2048;

struct Args {
    const float* in[28];
    float* out; unsigned char* ws;
    int ph_lo, ph_hi;
};

struct Frame {
    LAS unsigned char* lds;
    const float* in[28]; float* out; unsigned char* ws;
    int tid, lane, wave, G, vb;
};

enum { I_X = 0, I_META, I_NORM_MIX, I_W_IN, I_SSD_CONV_W, I_SSD_CONV_B, I_SSD_DT_BIAS, I_SSD_A_LOG, I_SSD_D, I_SSD_NORM, I_W_SSD_OUT, I_LRU_CONV_W, I_LRU_CONV_B, I_LRU_WA, I_LRU_BA, I_LRU_WX, I_LRU_BX,
       I_LRU_LAMBDA, I_W_LRU_OUT, I_GATE_BIAS, I_W_OUT, I_NORM_FFN, I_W_RG, I_W_RE, I_W_EG, I_W_EU, I_W_ED, I_NORM_FINAL };

__device__ __forceinline__ int seq_row(int b, int t) { return t < NMETA ? T + t : b * SEQ + (t - NMETA); }

__device__ __forceinline__ int rowmap(int kind, int n) {
    switch (kind) {
        case 1: return n < 6144 ? n : (n < 6176 ? n + 8192 : n - 32);
        case 2: case 4: return (n >> 7) * 256 + (n & 127);
        case 3: case 5: return (n >> 7) * 256 + 128 + (n & 127);
        default: return n;
    }
}
__device__ void tconv(const Frame& F, const float* __restrict__ src, int K, int N, bf16_t* __restrict__ dst, int ldd, int kind, int& tilebase) {
    const int nbk = K / 64, nbn = N / 32, nblk = nbk * nbn;
    const int gw = F.vb * 8 + F.wave, nw = F.G * 8;
    int first = (gw - tilebase) % nw; if (first < 0) first += nw;
    const int ng = F.lane & 7, kg = F.lane >> 3;
    for (int t = first; t < nblk; t += nw) {
        const int bk = t % nbk, bn = t / nbk;
        const int n = bn * 32 + 4 * ng, k = bk * 64 + 8 * kg;
        f32x4 v[8];
#pragma unroll
        for (int i = 0; i < 8; ++i) v[i] = *(const f32x4*)(src + (size_t)(k + i) * N + n);
#pragma unroll
        for (int j = 0; j < 4; ++j) {
            u32x4 w; w.x = cvt_pk_bf16(v[0][j], v[1][j]); w.y = cvt_pk_bf16(v[2][j], v[3][j]); w.z = cvt_pk_bf16(v[4][j], v[5][j]); w.w = cvt_pk_bf16(v[6][j], v[7][j]);
            *(u32x4*)(dst + (size_t)rowmap(kind, n + j) * ldd + k) = w;
        }
    }
    tilebase += nblk;
}

__device__ void p0_prologue(const Frame& F) {
    {
        bf16_t* U = (bf16_t*)(F.ws + WS_U);
        const float* g = F.in[I_NORM_MIX];
        for (int row = F.vb * 8 + F.wave; row < TR; row += F.G * 8) {
            const float* src = row < T ? F.in[I_X] + (size_t)row * D : F.in[I_META] + (size_t)(row - T) * D;
            f32x4 v[8]; float ss = 0.f;
#pragma unroll
            for (int i = 0; i < 8; ++i) { v[i] = *(const f32x4*)(src + i * 256 + F.lane * 4); ss += v[i][0] * v[i][0] + v[i][1] * v[i][1] + v[i][2] * v[i][2] + v[i][3] * v[i][3]; }
            ss = wave_sum(ss);
            const float rstd = rsqrtf(ss * (1.0f / D) + EPS);
#pragma unroll
            for (int i = 0; i < 8; ++i) {
                const f32x4 gg = *(const f32x4*)(g + i * 256 + F.lane * 4);
                u32x2 w; w.x = cvt_pk_bf16(v[i][0] * rstd * gg[0], v[i][1] * rstd * gg[1]); w.y = cvt_pk_bf16(v[i][2] * rstd * gg[2], v[i][3] * rstd * gg[3]);
                *(u32x2*)(U + (size_t)row * D + i * 256 + F.lane * 4) = w;
            }
        }
    }
    {
        bf16_t* WH = (bf16_t*)(F.ws + WS_WRH); bf16_t* WL = (bf16_t*)(F.ws + WS_WRL);
        const float* wrg = F.in[I_W_RG]; const float* wre = F.in[I_W_RE];
        for (int i = F.vb * NTHREADS + F.tid; i < 96 * 2048; i += F.G * NTHREADS) {
            const int n = i >> 11, k = i & 2047;
            const float v = n < 8 ? wrg[(size_t)k * 8 + n] : (n < 72 ? wre[(size_t)k * 64 + (n - 8)] : 0.f);
            const unsigned short hi = f2bf(v);
            WH[i] = hi; WL[i] = f2bf(v - bf2f(hi));
        }
    }
    int tb = 0;
    tconv(F, F.in[I_W_IN], 2048, 14368, (bf16_t*)(F.ws + WS_WIN), 2048, 1, tb);
    tconv(F, F.in[I_W_SSD_OUT], 2048, 2048, (bf16_t*)(F.ws + WS_WSO), 2048, 0, tb);
    tconv(F, F.in[I_W_LRU_OUT], 2048, 2048, (bf16_t*)(F.ws + WS_WLO), 2048, 0, tb);
    tconv(F, F.in[I_W_OUT], 2048, 2048, (bf16_t*)(F.ws + WS_WOUT), 2048, 0, tb);
    for (int h = 0; h < 8; ++h) {
        tconv(F, F.in[I_LRU_WA] + (size_t)h * 65536, 256, 256, (bf16_t*)(F.ws + WS_WLRU) + (size_t)h * 512 * 256, 256, 4, tb);
        tconv(F, F.in[I_LRU_WX] + (size_t)h * 65536, 256, 256, (bf16_t*)(F.ws + WS_WLRU) + (size_t)h * 512 * 256, 256, 5, tb);
    }
}

struct EpiProj {
    static constexpr bool PERM = true;
    bf16_t* P; const float* gate_bias;
    __device__ __forceinline__ void operator()(const f32x4 (&acc)[2][2][4][2], const pg8::Unit& u, int wr, int wc, int fr, int fq) const {
        const int row0 = u.pm * 256 + wr * 64 + fr, col0 = u.pn * 256 + wc * 32 + 8 * fq;
        const int kind = u.pn < 8 ? 0 : (u.pn < 32 ? 1 : (u.pn < 40 ? 2 : 3));
#pragma unroll
        for (int bj = 0; bj < 2; ++bj) {
            f32x4 b0 = (f32x4){0.f, 0.f, 0.f, 0.f}, b1 = b0;
            if (kind == 3) { b0 = *(const f32x4*)(gate_bias + (col0 + bj * 128 - OGL)); b1 = *(const f32x4*)(gate_bias + (col0 + bj * 128 - OGL) + 4); }
#pragma unroll
            for (int ai = 0; ai < 2; ++ai)
#pragma unroll
                for (int m = 0; m < 4; ++m) {
                    f32x4 v0 = acc[ai][bj][m][0], v1 = acc[ai][bj][m][1];
                    if (kind == 0) {
#pragma unroll
                        for (int j = 0; j < 4; ++j) { v0[j] = siluf_(v0[j]); v1[j] = siluf_(v1[j]); }
                    } else if (kind == 2) {
#pragma unroll
                        for (int j = 0; j < 4; ++j) { v0[j] = gelu_tanh_(v0[j]); v1[j] = gelu_tanh_(v1[j]); }
                    } else if (kind == 3) {
#pragma unroll
                        for (int j = 0; j < 4; ++j) { v0[j] = sigmoidf_(v0[j] + b0[j]); v1[j] = sigmoidf_(v1[j] + b1[j]); }
                    }
                    u32x4 w; w.x = cvt_pk_bf16(v0[0], v0[1]); w.y = cvt_pk_bf16(v0[2], v0[3]); w.z = cvt_pk_bf16(v1[0], v1[1]); w.w = cvt_pk_bf16(v1[2], v1[3]);
                    *(u32x4*)(P + (size_t)(row0 + ai * 128 + m * 16) * NP + col0 + bj * 128) = w;
                }
        }
    }
};

struct EpiLru {
    static constexpr bool PERM = true;
    const bf16_t* XR; bf16_t* LOGA; bf16_t* LU; const float* ba; const float* bx; const float* lam;
    __device__ __forceinline__ void operator()(const f32x4 (&acc)[2][2][4][2], const pg8::Unit& u, int wr, int wc, int fr, int fq) const {
        const int row0 = u.pm * 256 + wr * 64 + fr;
#pragma unroll
        for (int n = 0; n < 2; ++n) {
            const int ch0 = (u.pn >> 1) * 256 + (u.pn & 1) * 128 + wc * 32 + 8 * fq + 4 * n;
            const f32x4 bav = *(const f32x4*)(ba + ch0), bxv = *(const f32x4*)(bx + ch0), lmv = *(const f32x4*)(lam + ch0);
            f32x4 spl;
#pragma unroll
            for (int j = 0; j < 4; ++j) spl[j] = -8.0f * softplusf_(-lmv[j]);
            u32x2 xq[8];
#pragma unroll
            for (int q = 0; q < 8; ++q) { const bf16_t* xp = XR + (size_t)(row0 + (q >> 2) * 128 + (q & 3) * 16) * D + ch0; asm volatile("global_load_dwordx2 %0, %1, off" : "=v"(xq[q]) : "v"(xp) : "memory"); }
            asm volatile("s_waitcnt vmcnt(0)" : "+v"(xq[0]), "+v"(xq[1]), "+v"(xq[2]), "+v"(xq[3]), "+v"(xq[4]), "+v"(xq[5]), "+v"(xq[6]), "+v"(xq[7]) :: "memory");
#pragma unroll
            for (int ai = 0; ai < 2; ++ai)
#pragma unroll
                for (int m = 0; m < 4; ++m) {
                    const size_t off = (size_t)(row0 + ai * 128 + m * 16) * D + ch0;
                    const u32x2 xw = xq[ai * 4 + m];
                    const float xr[4] = {bflo(xw.x), bfhi(xw.x), bflo(xw.y), bfhi(xw.y)};
                    float la[4], uu[4];
#pragma unroll
                    for (int j = 0; j < 4; ++j) {
                        const float pr = acc[ai][0][m][n][j] + bav[j], pi = acc[ai][1][m][n][j] + bxv[j];
                        const float l = spl[j] * sigmoidf_(pr);
                        la[j] = l;
                        uu[j] = __builtin_amdgcn_sqrtf(fmaxf(1.0f - __expf(2.0f * l), 0.0f)) * sigmoidf_(pi) * xr[j];
                    }
                    u32x2 w; w.x = cvt_pk_bf16(la[0], la[1]); w.y = cvt_pk_bf16(la[2], la[3]);
                    *(u32x2*)(LOGA + off) = w;
                    w.x = cvt_pk_bf16(uu[0], uu[1]); w.y = cvt_pk_bf16(uu[2], uu[3]);
                    *(u32x2*)(LU + off) = w;
                }
        }
    }
};

struct EpiMixPair {
    static constexpr bool PERM = true;
    const bf16_t* P; bf16_t* MIX;
    __device__ __forceinline__ void first(f32x4 (&acc)[2][2][4][2], const pg8::Unit& u, int wr, int wc, int fr, int fq) const {
        const int row0 = u.pm * 256 + wr * 64 + fr, col0 = u.pn * 256 + wc * 32 + 8 * fq;
#pragma unroll
        for (int ai = 0; ai < 2; ++ai)
#pragma unroll
            for (int m = 0; m < 4; ++m)
#pragma unroll
                for (int bj = 0; bj < 2; ++bj) {
                    const size_t go = (size_t)(row0 + ai * 128 + m * 16) * NP + OGL + col0 + bj * 128;
                    const u32x4 a = *(const u32x4*)(P + go), b = *(const u32x4*)(P + go + D);
                    const float r[8] = {bflo(a.x) * __builtin_amdgcn_rcpf(bflo(b.x)), bfhi(a.x) * __builtin_amdgcn_rcpf(bfhi(b.x)), bflo(a.y) * __builtin_amdgcn_rcpf(bflo(b.y)), bfhi(a.y) * __builtin_amdgcn_rcpf(bfhi(b.y)),
                                        bflo(a.z) * __builtin_amdgcn_rcpf(bflo(b.z)), bfhi(a.z) * __builtin_amdgcn_rcpf(bfhi(b.z)), bflo(a.w) * __builtin_amdgcn_rcpf(bflo(b.w)), bfhi(a.w) * __builtin_amdgcn_rcpf(bfhi(b.w))};
#pragma unroll
                    for (int j = 0; j < 4; ++j) { acc[ai][bj][m][0][j] *= r[j]; acc[ai][bj][m][1][j] *= r[4 + j]; }
                }
    }
    __device__ __forceinline__ void operator()(const f32x4 (&acc)[2][2][4][2], const pg8::Unit& u, int wr, int wc, int fr, int fq) const {
        const int row0 = u.pm * 256 + wr * 64 + fr, col0 = u.pn * 256 + wc * 32 + 8 * fq;
#pragma unroll
        for (int ai = 0; ai < 2; ++ai)
#pragma unroll
            for (int m = 0; m < 4; ++m)
#pragma unroll
                for (int bj = 0; bj < 2; ++bj) {
                    const int row = row0 + ai * 128 + m * 16, col = col0 + bj * 128;
                    const u32x4 gw = *(const u32x4*)(P + (size_t)row * NP + OGL + D + col);
                    const float g[8] = {bflo(gw.x), bfhi(gw.x), bflo(gw.y), bfhi(gw.y), bflo(gw.z), bfhi(gw.z), bflo(gw.w), bfhi(gw.w)};
                    f32x4 v0 = acc[ai][bj][m][0], v1 = acc[ai][bj][m][1];
#pragma unroll
                    for (int j = 0; j < 4; ++j) { v0[j] *= g[j]; v1[j] *= g[4 + j]; }
                    u32x4 w; w.x = cvt_pk_bf16(v0[0], v0[1]); w.y = cvt_pk_bf16(v0[2], v0[3]); w.z = cvt_pk_bf16(v1[0], v1[1]); w.w = cvt_pk_bf16(v1[2], v1[3]);
                    *(u32x4*)(MIX + (size_t)row * D + col) = w;
                }
    }
};

struct EpiRes {
    static constexpr bool PERM = false;
    const float* X; float* H1;
    __device__ __forceinline__ void operator()(const f32x4 (&acc)[2][2][4][2], const pg8::Unit& u, int wr, int wc, int fr, int fq) const {
        const int row0 = u.pm * 256 + wr * 64 + fr, col0 = u.pn * 256 + wc * 32 + 4 * fq;
#pragma unroll
        for (int ai = 0; ai < 2; ++ai)
#pragma unroll
            for (int m = 0; m < 4; ++m)
#pragma unroll
                for (int bj = 0; bj < 2; ++bj)
#pragma unroll
                    for (int n = 0; n < 2; ++n) {
                        const size_t off = (size_t)(row0 + ai * 128 + m * 16) * D + col0 + bj * 128 + n * 16;
                        *(f32x4*)(H1 + off) = *(const f32x4*)(X + off) + acc[ai][bj][m][n];
                    }
    }
};

struct EpiMoe1 {
    static constexpr bool PERM = true;
    bf16_t* H; LAS const unsigned char* rowtbl;
    __device__ __forceinline__ void operator()(const f32x4 (&acc)[2][2][4][2], const pg8::Unit& u, int wr, int wc, int fr, int fq) const {
        const int lrow0 = wr * 64 + fr, row0 = u.pm * 256 + lrow0, col0 = u.pn * 128 + wc * 32 + 8 * fq;
        const LAS float* tv = (const LAS float*)(rowtbl + u.par * 2048 + 1024);
#pragma unroll
        for (int ai = 0; ai < 2; ++ai)
#pragma unroll
            for (int m = 0; m < 4; ++m) {
                const float rs = tv[lrow0 + ai * 128 + m * 16];
                float h[8];
#pragma unroll
                for (int j = 0; j < 8; ++j) h[j] = siluf_(rs * acc[ai][0][m][j >> 2][j & 3]) * (rs * acc[ai][1][m][j >> 2][j & 3]);
                u32x4 w; w.x = cvt_pk_bf16(h[0], h[1]); w.y = cvt_pk_bf16(h[2], h[3]); w.z = cvt_pk_bf16(h[4], h[5]); w.w = cvt_pk_bf16(h[6], h[7]);
                *(u32x4*)(H + (size_t)(row0 + ai * 128 + m * 16) * FF + col0) = w;
            }
    }
};

struct EpiMoe2 {
    static constexpr bool PERM = true;
    bf16_t* Y; LAS const unsigned char* rowtbl;
    __device__ __forceinline__ void operator()(const f32x4 (&acc)[2][2][4][2], const pg8::Unit& u, int wr, int wc, int fr, int fq) const {
        const int lrow0 = wr * 64 + fr, col0 = u.pn * 256 + wc * 32 + 8 * fq;
        const LAS int* te = (const LAS int*)(rowtbl + u.par * 2048);
        const LAS float* tv = (const LAS float*)(rowtbl + u.par * 2048 + 1024);
#pragma unroll
        for (int ai = 0; ai < 2; ++ai)
#pragma unroll
            for (int m = 0; m < 4; ++m) {
                const int lr = lrow0 + ai * 128 + m * 16;
                if (lr < u.cnt) {
                    const int ent = te[lr]; const float g = tv[lr];
#pragma unroll
                    for (int bj = 0; bj < 2; ++bj) {
                        const f32x4 v0 = acc[ai][bj][m][0] * g, v1 = acc[ai][bj][m][1] * g;
                        u32x4 w; w.x = cvt_pk_bf16(v0[0], v0[1]); w.y = cvt_pk_bf16(v0[2], v0[3]); w.z = cvt_pk_bf16(v1[0], v1[1]); w.w = cvt_pk_bf16(v1[2], v1[3]);
                        *(u32x4*)(Y + (size_t)ent * D + col0 + bj * 128) = w;
                    }
                }
            }
    }
};

__device__ void p1_thin(const Frame& F) {
    const bf16_t* U = (const bf16_t*)(F.ws + WS_U);
    const bf16_t* W = (const bf16_t*)(F.ws + WS_WIN);
    bf16_t* P = (bf16_t*)(F.ws + WS_PROJ);
    float* DT = (float*)(F.ws + WS_DT);
    const int NDT = 513, NMT = 192, NIT = NDT + NMT;
    LAS float* red = (LAS float*)F.lds;
    const int r = F.lane & 31, h = F.lane >> 5, quad = F.wave >> 2, kq = F.wave & 3;
    for (int base = F.vb * 2; base < NIT; base += F.G * 2) {
        const int it = base + quad;
        const bool act = it < NIT;
        int row0 = 0, bcol0 = NP, nvalid = 0;
        if (act) {
            if (it < NDT) { row0 = it * 32; bcol0 = NP; nvalid = (TR - row0) < 32 ? (TR - row0) : 32; }
            else { row0 = T; bcol0 = OXBC + (it - NDT) * 32; nvalid = 16; }
        }
        f32x16 acc;
#pragma unroll
        for (int j = 0; j < 16; ++j) acc[j] = 0.f;
        if (act) {
            const int arow = row0 + (r < nvalid ? r : 0);
            const bf16_t* ap = U + (size_t)arow * D + kq * 512 + 8 * h;
            const bf16_t* bp = W + (size_t)(bcol0 + r) * D + kq * 512 + 8 * h;
#pragma unroll 1
            for (int kb = 0; kb < 512; kb += 128) {
                bf16x8 fa[8], fb[8];
#pragma unroll
                for (int k = 0; k < 8; ++k) { fa[k] = *(const bf16x8*)(ap + kb + k * 16); fb[k] = *(const bf16x8*)(bp + kb + k * 16); }
                __builtin_amdgcn_sched_barrier(0);
#pragma unroll
                for (int k = 0; k < 8; ++k) acc = __builtin_amdgcn_mfma_f32_32x32x16_bf16(fa[k], fb[k], acc, 0, 0, 0);
            }
        }
#pragma unroll
        for (int j = 0; j < 16; ++j) red[((quad * 4 + kq) * 16 + j) * 64 + F.lane] = acc[j];
        __syncthreads();
        if (act && kq == 0) {
#pragma unroll
            for (int j = 0; j < 16; ++j) {
                const float v = (red[((quad * 4 + 0) * 16 + j) * 64 + F.lane] + red[((quad * 4 + 1) * 16 + j) * 64 + F.lane]) + (red[((quad * 4 + 2) * 16 + j) * 64 + F.lane] + red[((quad * 4 + 3) * 16 + j) * 64 + F.lane]);
                const int i = (j & 3) + 8 * (j >> 2) + 4 * h;
                if (i < nvalid) {
                    if (it < NDT) DT[(size_t)(row0 + i) * 32 + r] = v;
                    else P[(size_t)(row0 + i) * NP + bcol0 + r] = f2bf(v);
                }
            }
        }
        __syncthreads();
    }
}

__device__ void p2_conv(const Frame& F) {
    const bf16_t* P = (const bf16_t*)(F.ws + WS_PROJ);
    bf16_t* XR = (bf16_t*)(F.ws + WS_XR);
    bf16_t* XS = (bf16_t*)(F.ws + WS_XBCS);
    const int cgl = F.tid & 255, rsel = F.tid >> 8;
    constexpr int NU_X = 3 * NBATCH * 128, NU = NU_X + 3;
    for (int u = F.vb; u < NU; u += F.G) {
        int cbk, b, t0;
        if (u < NU_X) { cbk = u % 3; const int q = u / 3; b = q >> 7; t0 = NMETA + ((q & 127) * 2 + rsel) * 8; }
        else { cbk = u - NU_X; b = 0; t0 = rsel * 8; }
        const int cgx = cbk * 256 + cgl;
        const bool isx = cgx < 512;
        const int c0 = isx ? cgx * 8 : (cgx - 512) * 8;
        const float* cw = isx ? F.in[I_SSD_CONV_W] : F.in[I_LRU_CONV_W];
        const float* cb = isx ? F.in[I_SSD_CONV_B] : F.in[I_LRU_CONV_B];
        const int cwld = isx ? 4096 : D;
        const int pcol = (isx ? OXBC : OLX) + c0;
        u32x4 raw[11];
        if (u < NU_X) {
#pragma unroll
            for (int m = 0; m < 11; ++m) raw[m] = *(const u32x4*)(P + (size_t)seq_row(b, t0 - 3 + m) * NP + pcol);
        } else {
#pragma unroll
            for (int m = 0; m < 11; ++m) { const int t = t0 - 3 + m; const u32x4 v = *(const u32x4*)(P + (size_t)seq_row(b, t < 0 ? 0 : t) * NP + pcol); raw[m] = t >= 0 ? v : (u32x4){0u, 0u, 0u, 0u}; }
        }
        u32x2 outw[8][2];
#pragma unroll
        for (int hh = 0; hh < 2; ++hh) {
            const f32x4 b0 = *(const f32x4*)(cb + c0 + 4 * hh);
            f32x4 wg[4];
#pragma unroll
            for (int k = 0; k < 4; ++k) wg[k] = *(const f32x4*)(cw + k * cwld + c0 + 4 * hh);
            f32x4 o[8];
#pragma unroll
            for (int i = 0; i < 8; ++i) o[i] = b0;
#pragma unroll
            for (int m = 0; m < 11; ++m) {
                const unsigned d0 = hh ? raw[m].z : raw[m].x, d1 = hh ? raw[m].w : raw[m].y;
                const f32x4 x = (f32x4){bflo(d0), bfhi(d0), bflo(d1), bfhi(d1)};
#pragma unroll
                for (int k = 0; k < 4; ++k) { const int i = m - k; if (i >= 0 && i < 8) o[i] += wg[k] * x; }
            }
#pragma unroll
            for (int i = 0; i < 8; ++i) {
                f32x4 v = o[i];
                if (isx) { v[0] = siluf_(v[0]); v[1] = siluf_(v[1]); v[2] = siluf_(v[2]); v[3] = siluf_(v[3]); }
                outw[i][hh].x = cvt_pk_bf16(v[0], v[1]); outw[i][hh].y = cvt_pk_bf16(v[2], v[3]);
            }
        }
#pragma unroll
        for (int i = 0; i < 8; ++i) {
            const size_t row = (size_t)seq_row(b, t0 + i);
            u32x4 w; w.x = outw[i][0].x; w.y = outw[i][0].y; w.z = outw[i][1].x; w.w = outw[i][1].y;
            if (isx) *(u32x4*)(XS + row * 4096 + c0) = w; else *(u32x4*)(XR + row * D + c0) = w;
        }
    }
}

__device__ __forceinline__ float ssd_dtload(const float* DT, int b, int head, int ci, int lane) {
    const int t = ci * 64 - 48 + lane;
    return t >= 0 ? DT[(size_t)seq_row(b, t) * 32 + head] : 0.f;
}
__device__ __forceinline__ void ssd_scal(float dtraw, int ci, float dtb, float a_neg, LAS float* scb, int lane) {
    const int t = ci * 64 - 48 + lane;
    float dtv = 0.f;
    if (t >= 0) dtv = softplusf_(dtraw + dtb);
    float cs = dtv * a_neg;
#pragma unroll
    for (int o = 1; o < 64; o <<= 1) { const float v = __shfl_up(cs, o); if (lane >= o) cs += v; }
    const float tot = __shfl(cs, 63);
    scb[lane] = cs; scb[64 + lane] = dtv; scb[128 + lane] = dtv * __expf(tot - cs);
}
__device__ __forceinline__ void ssd_writeout(const LAS unsigned char* yb, const u32x4 zw, bf16_t* dst) {
    const f32x4 y0 = *(const LAS f32x4*)yb, y1 = *(const LAS f32x4*)(yb + 16);
    u32x4 w; w.x = cvt_pk_bf16(y0[0] * bflo(zw.x), y0[1] * bfhi(zw.x)); w.y = cvt_pk_bf16(y0[2] * bflo(zw.y), y0[3] * bfhi(zw.y));
    w.z = cvt_pk_bf16(y1[0] * bflo(zw.z), y1[1] * bfhi(zw.z)); w.w = cvt_pk_bf16(y1[2] * bflo(zw.w), y1[3] * bfhi(zw.w));
    *(u32x4*)dst = w;
}
constexpr int W2_BLOCKS = NEXP * (D / 32) * (FF / 64);
__device__ __forceinline__ void w2_issue(const float* __restrict__ w2, int blk, int lane, f32x4 (&v)[8]) {
    const int e = blk >> 10, bn = (blk >> 4) & 63, bk = blk & 15, ng = lane & 7, kg = lane >> 3;
    const float* src = w2 + (size_t)e * FF * D + (size_t)(bk * 64 + 8 * kg) * D + bn * 32 + 4 * ng;
#pragma unroll
    for (int i = 0; i < 8; ++i) v[i] = *(const f32x4*)(src + (size_t)i * D);
}
__device__ __forceinline__ void w2_commit(bf16_t* __restrict__ w2t, int blk, int lane, const f32x4 (&v)[8]) {
    const int e = blk >> 10, bn = (blk >> 4) & 63, bk = blk & 15, ng = lane & 7, kg = lane >> 3;
    bf16_t* dst = w2t + (size_t)e * D * FF + (size_t)(bn * 32 + 4 * ng) * FF + bk * 64 + 8 * kg;
#pragma unroll
    for (int j = 0; j < 4; ++j) {
        u32x4 w; w.x = cvt_pk_bf16(v[0][j], v[1][j]); w.y = cvt_pk_bf16(v[2][j], v[3][j]); w.z = cvt_pk_bf16(v[4][j], v[5][j]); w.w = cvt_pk_bf16(v[6][j], v[7][j]);
        *(u32x4*)(dst + (size_t)j * FF) = w;
    }
}
__device__ void p2_ssd_chunk(const Frame& F) {
    const bf16_t* P = (const bf16_t*)(F.ws + WS_PROJ);
    const float* DT = (const float*)(F.ws + WS_DT);
    bf16_t* Y = (bf16_t*)(F.ws + WS_YSSD);
    const bf16_t* XS = (const bf16_t*)(F.ws + WS_XBCS);
    LAS unsigned char* L = F.lds;
    constexpr int RSN = 272, RSS = 144;
    constexpr int O_CM = 0, O_BM = O_CM + 64 * RSN, O_BMT = O_BM + 64 * RSN, O_XST = O_BMT + 128 * RSS, O_XWT = O_XST + 64 * RSS, O_MM = O_XWT + 64 * RSS,
                  O_ST0 = O_MM + 64 * RSS, O_ST1 = O_ST0 + 64 * RSN, O_SC = O_ST1 + 64 * RSN, O_YB = O_SC + 2 * 192 * 4;
    static_assert(O_YB + 64 * RSN <= LDS_WORK, "ssd lds");
    LAS float* sc = (LAS float*)(L + O_SC);
    const int tid = F.tid, lane = F.lane, wave = F.wave, r = lane & 31, h = lane >> 5;
    const bool cv = tid < 320;
    const int cg = tid >> 3, run = tid & 7, i0 = run * 8;
    const float* W2 = F.in[I_W_ED]; bf16_t* W2T = (bf16_t*)(F.ws + WS_W2);
    f32x4 cb0[8];
    int cstep = 0;
    for (int unit = F.vb; unit < NBATCH * NHEAD; unit += F.G) {
        const int b = unit >> 5, head = unit & 31, grp = head >> 2;
        const float a_neg = -__expf(F.in[I_SSD_A_LOG][head]), dtb = F.in[I_SSD_DT_BIAS][head], dsk = F.in[I_SSD_D][head];
        const int cc = cg < 8 ? head * 64 + cg * 8 : (cg < 24 ? 2048 + grp * 128 + (cg - 8) * 8 : 3072 + grp * 128 + (cg - 24) * 8);
        f32x16 st0, st1;
#pragma unroll
        for (int j = 0; j < 16; ++j) { st0[j] = 0.f; st1[j] = 0.f; }
        for (int i = tid; i < 64 * RSN / 16; i += NTHREADS) *(LAS u32x4*)(L + O_ST0 + i * 16) = (u32x4){0u, 0u, 0u, 0u};
        u32x4 raw[8];
        if (cv) {
#pragma unroll
            for (int i = 0; i < 8; ++i) { const int t = -48 + i0 + i; raw[i] = (u32x4){0u, 0u, 0u, 0u}; if (t >= 0) raw[i] = *(const u32x4*)(XS + (size_t)seq_row(b, t) * 4096 + cc); }
        }
        float dtn = 0.f;
        if (wave == 7) { ssd_scal(ssd_dtload(DT, b, head, 0, lane), 0, dtb, a_neg, sc, lane); dtn = ssd_dtload(DT, b, head, 1, lane); }
        u32x4 zw = (u32x4){0u, 0u, 0u, 0u};
        __syncthreads();
        for (int ci = 0; ci < 33; ++ci) {
            LAS float* scc = sc + (ci & 1) * 192;
            const int stc = (ci & 1) ? O_ST1 : O_ST0, stn = (ci & 1) ? O_ST0 : O_ST1;
            const int wl = tid >> 3, wc8 = (tid & 7) * 8;
            if (cv) {
                if (cg >= 8) {
                    const int n0 = cg < 24 ? (cg - 8) * 8 : (cg - 24) * 8;
                    const int ob = cg < 24 ? O_BM : O_CM;
#pragma unroll
                    for (int i = 0; i < 8; ++i) *(LAS u32x4*)(L + ob + (i0 + i) * RSN + n0 * 2) = raw[i];
                }
                if (cg < 24) {
                    const int n0 = cg < 8 ? cg * 8 : (cg - 8) * 8;
                    const int ob = cg < 8 ? O_XST : O_BMT;
#pragma unroll
                    for (int d = 0; d < 4; ++d) {
                        u32x4 lo, hi;
                        lo.x = (raw[0][d] & 0xffffu) | (raw[1][d] << 16); lo.y = (raw[2][d] & 0xffffu) | (raw[3][d] << 16); lo.z = (raw[4][d] & 0xffffu) | (raw[5][d] << 16); lo.w = (raw[6][d] & 0xffffu) | (raw[7][d] << 16);
                        hi.x = (raw[0][d] >> 16) | (raw[1][d] & 0xffff0000u); hi.y = (raw[2][d] >> 16) | (raw[3][d] & 0xffff0000u); hi.z = (raw[4][d] >> 16) | (raw[5][d] & 0xffff0000u); hi.w = (raw[6][d] >> 16) | (raw[7][d] & 0xffff0000u);
                        *(LAS u32x4*)(L + ob + (n0 + 2 * d) * RSS + i0 * 2) = lo;
                        *(LAS u32x4*)(L + ob + (n0 + 2 * d + 1) * RSS + i0 * 2) = hi;
                    }
                    if (cg < 8) {
                        const f32x4 w0 = *(const LAS f32x4*)(scc + 128 + i0), w1 = *(const LAS f32x4*)(scc + 128 + i0 + 4);
#pragma unroll
                        for (int d = 0; d < 4; ++d) {
                            u32x4 lo, hi;
                            lo.x = cvt_pk_bf16(bflo(raw[0][d]) * w0[0], bflo(raw[1][d]) * w0[1]); lo.y = cvt_pk_bf16(bflo(raw[2][d]) * w0[2], bflo(raw[3][d]) * w0[3]);
                            lo.z = cvt_pk_bf16(bflo(raw[4][d]) * w1[0], bflo(raw[5][d]) * w1[1]); lo.w = cvt_pk_bf16(bflo(raw[6][d]) * w1[2], bflo(raw[7][d]) * w1[3]);
                            hi.x = cvt_pk_bf16(bfhi(raw[0][d]) * w0[0], bfhi(raw[1][d]) * w0[1]); hi.y = cvt_pk_bf16(bfhi(raw[2][d]) * w0[2], bfhi(raw[3][d]) * w0[3]);
                            hi.z = cvt_pk_bf16(bfhi(raw[4][d]) * w1[0], bfhi(raw[5][d]) * w1[1]); hi.w = cvt_pk_bf16(bfhi(raw[6][d]) * w1[2], bfhi(raw[7][d]) * w1[3]);
                            *(LAS u32x4*)(L + O_XWT + (n0 + 2 * d) * RSS + i0 * 2) = lo;
                            *(LAS u32x4*)(L + O_XWT + (n0 + 2 * d + 1) * RSS + i0 * 2) = hi;
                        }
                    }
                }
            }
            if (wave == 7 && ci + 1 < 33) ssd_scal(dtn, ci + 1, dtb, a_neg, sc + ((ci + 1) & 1) * 192, lane);
            if (ci > 1) ssd_writeout(L + O_YB + wl * RSN + wc8 * 4, zw, Y + ((size_t)b * SEQ + (ci - 2) * 64 + wl) * D + head * 64 + wc8);
            if (wave >= 4) {
                if (cstep > 0) { const int ib = ((cstep - 1) * 8 + wave) * F.G + F.vb; if (ib < W2_BLOCKS) w2_commit(W2T, ib, lane, cb0); }
                { const int ib = (cstep * 8 + wave) * F.G + F.vb; if (ib < W2_BLOCKS) w2_issue(W2, ib, lane, cb0); }
            }
            __syncthreads();
            if (cv && ci + 1 < 33) {
#pragma unroll
                for (int i = 0; i < 8; ++i) raw[i] = *(const u32x4*)(XS + (size_t)seq_row(b, (ci + 1) * 64 - 48 + i0 + i) * 4096 + cc);
            }
            if (ci > 0) zw = *(const u32x4*)(P + ((size_t)b * SEQ + (ci - 1) * 64 + wl) * NP + OZ + head * 64 + wc8);
            if (wave == 7 && ci + 2 < 33) dtn = ssd_dtload(DT, b, head, ci + 2, lane);
            if (wave < 4) {
                if (wave < 3) {
                    const int lb = wave > 0 ? 1 : 0, sb = wave == 2 ? 1 : 0;
                    f32x16 acc;
#pragma unroll
                    for (int j = 0; j < 16; ++j) acc[j] = 0.f;
                    const LAS unsigned char* ap = L + O_CM + (lb * 32 + r) * RSN + h * 16;
                    const LAS unsigned char* bp = L + O_BM + (sb * 32 + r) * RSN + h * 16;
#pragma unroll
                    for (int k = 0; k < 8; ++k) acc = __builtin_amdgcn_mfma_f32_32x32x16_bf16(*(const LAS bf16x8*)(ap + k * 32), *(const LAS bf16x8*)(bp + k * 32), acc, 0, 0, 0);
                    const int s = sb * 32 + r; const float acs = scc[s], dts = scc[64 + s];
#pragma unroll
                    for (int g = 0; g < 4; ++g) {
                        const int lbase = lb * 32 + 8 * g + 4 * h;
                        const f32x4 acl = *(const LAS f32x4*)(scc + lbase);
#pragma unroll
                        for (int e = 0; e < 4; ++e) { const int l = lbase + e; const float v = (s <= l) ? acc[g * 4 + e] * __expf(acl[e] - acs) * dts : 0.f;
                            *(LAS unsigned short*)(L + O_MM + l * RSS + s * 2) = f2bf(v); }
                    }
                }
                {
                    const int pb = wave & 1, nb0 = (wave >> 1) * 2;
                    const float dec = __expf(scc[63]);
#pragma unroll
                    for (int j = 0; j < 16; ++j) { st0[j] *= dec; st1[j] *= dec; }
                    const LAS unsigned char* ap = L + O_XWT + (pb * 32 + r) * RSS + h * 16;
                    const LAS unsigned char* bp0 = L + O_BMT + (nb0 * 32 + r) * RSS + h * 16;
                    const LAS unsigned char* bp1 = bp0 + 32 * RSS;
#pragma unroll
                    for (int k = 0; k < 4; ++k) {
                        const bf16x8 a = *(const LAS bf16x8*)(ap + k * 32);
                        st0 = __builtin_amdgcn_mfma_f32_32x32x16_bf16(a, *(const LAS bf16x8*)(bp0 + k * 32), st0, 0, 0, 0);
                        st1 = __builtin_amdgcn_mfma_f32_32x32x16_bf16(a, *(const LAS bf16x8*)(bp1 + k * 32), st1, 0, 0, 0);
                    }
#pragma unroll
                    for (int g = 0; g < 4; ++g)
#pragma unroll
                        for (int e = 0; e < 4; ++e) {
                            const int p = pb * 32 + 8 * g + 4 * h + e;
                            *(LAS unsigned short*)(L + stn + p * RSN + (nb0 * 32 + r) * 2) = f2bf(st0[g * 4 + e]);
                            *(LAS unsigned short*)(L + stn + p * RSN + (nb0 * 32 + 32 + r) * 2) = f2bf(st1[g * 4 + e]);
                        }
                }
            } else {
                const int q = wave - 4, lb = q >> 1, pb = q & 1;
#pragma unroll
                for (int j = 0; j < 16; ++j) st0[j] = 0.f;
                const LAS unsigned char* ap = L + O_CM + (lb * 32 + r) * RSN + h * 16;
                const LAS unsigned char* bp = L + stc + (pb * 32 + r) * RSN + h * 16;
#pragma unroll
                for (int k = 0; k < 8; ++k) st0 = __builtin_amdgcn_mfma_f32_32x32x16_bf16(*(const LAS bf16x8*)(ap + k * 32), *(const LAS bf16x8*)(bp + k * 32), st0, 0, 0, 0);
#pragma unroll
                for (int g = 0; g < 4; ++g) {
                    const f32x4 acl = *(const LAS f32x4*)(scc + lb * 32 + 8 * g + 4 * h);
#pragma unroll
                    for (int e = 0; e < 4; ++e) st0[g * 4 + e] *= __expf(acl[e]);
                }
            }
            __syncthreads();
            if (wave < 4) {
                if (cstep > 0) { const int ib = ((cstep - 1) * 8 + wave) * F.G + F.vb; if (ib < W2_BLOCKS) w2_commit(W2T, ib, lane, cb0); }
                { const int ib = (cstep * 8 + wave) * F.G + F.vb; if (ib < W2_BLOCKS) w2_issue(W2, ib, lane, cb0); }
            }
            ++cstep;
            if (wave >= 4) {
                const int q = wave - 4, lb = q >> 1, pb = q & 1;
                const LAS unsigned char* ap = L + O_MM + (lb * 32 + r) * RSS + h * 16;
                const LAS unsigned char* bp = L + O_XST + (pb * 32 + r) * RSS + h * 16;
#pragma unroll
                for (int k = 0; k < 4; ++k) if (k < 2 * (lb + 1)) st0 = __builtin_amdgcn_mfma_f32_32x32x16_bf16(*(const LAS bf16x8*)(ap + k * 32), *(const LAS bf16x8*)(bp + k * 32), st0, 0, 0, 0);
                if (ci > 0) {
                    const int p = pb * 32 + r;
#pragma unroll
                    for (int g = 0; g < 4; ++g)
#pragma unroll
                        for (int e = 0; e < 4; ++e) {
                            const int l = lb * 32 + 8 * g + 4 * h + e;
                            const float xs = bf2f(*(const LAS unsigned short*)(L + O_XST + p * RSS + l * 2));
                            *(LAS float*)(L + O_YB + l * RSN + p * 4) = st0[g * 4 + e] + dsk * xs;
                        }
                }
            }
            __syncthreads();
        }
        {
            const int wl = tid >> 3, wc8 = (tid & 7) * 8;
            ssd_writeout(L + O_YB + wl * RSN + wc8 * 4, zw, Y + ((size_t)b * SEQ + 31 * 64 + wl) * D + head * 64 + wc8);
            __syncthreads();
        }
    }
    {
        if (cstep > 0) { const int ib = ((cstep - 1) * 8 + wave) * F.G + F.vb; if (ib < W2_BLOCKS) w2_commit(W2T, ib, lane, cb0); }
        for (int st = cstep; (st * 8 + wave) * F.G + F.vb < W2_BLOCKS; ++st) { const int ib = (st * 8 + wave) * F.G + F.vb; w2_issue(W2, ib, lane, cb0); w2_commit(W2T, ib, lane, cb0); }
    }
}

__device__ void p3_lru_meta(const Frame& F) {
    const bf16_t* XR = (const bf16_t*)(F.ws + WS_XR);
    const bf16_t* W = (const bf16_t*)(F.ws + WS_WLRU);
    bf16_t* LOGA = (bf16_t*)(F.ws + WS_LOGA); bf16_t* LU = (bf16_t*)(F.ws + WS_LU);
    const float* ba = F.in[I_LRU_BA]; const float* bx = F.in[I_LRU_BX]; const float* lam = F.in[I_LRU_LAMBDA];
    const int r = F.lane & 31, h = F.lane >> 5;
    for (int it = F.vb * 8 + F.wave; it < 64; it += F.G * 8) {
        const int head = it >> 3, c32 = it & 7;
        const bf16_t* ap = XR + (size_t)(T + (r < NMETA ? r : 0)) * D + head * 256 + 8 * h;
        const bf16_t* bpr = W + ((size_t)head * 512 + (c32 >> 2) * 256 + (c32 & 3) * 32 + r) * 256 + 8 * h;
        const bf16_t* bpi = bpr + 128 * 256;
        f32x16 ar, ai;
#pragma unroll
        for (int j = 0; j < 16; ++j) { ar[j] = 0.f; ai[j] = 0.f; }
#pragma unroll
        for (int k0 = 0; k0 < 256; k0 += 16) {
            const bf16x8 a = *(const bf16x8*)(ap + k0);
            ar = __builtin_amdgcn_mfma_f32_32x32x16_bf16(a, *(const bf16x8*)(bpr + k0), ar, 0, 0, 0);
            ai = __builtin_amdgcn_mfma_f32_32x32x16_bf16(a, *(const bf16x8*)(bpi + k0), ai, 0, 0, 0);
        }
        const int ch = head * 256 + c32 * 32 + r;
        const float bav = ba[ch], bxv = bx[ch], spl = -8.0f * softplusf_(-lam[ch]);
#pragma unroll
        for (int j = 0; j < 8; ++j) {
            const int row = (j & 3) + 8 * (j >> 2) + 4 * h;
            const size_t off = (size_t)(T + row) * D + ch;
            const float l = spl * sigmoidf_(ar[j] + bav);
            const float u = sqrtf(fmaxf(1.0f - __expf(2.0f * l), 0.0f)) * sigmoidf_(ai[j] + bxv) * bf2f(XR[off]);
            LOGA[off] = f2bf(l); LU[off] = f2bf(u);
        }
    }
}

__device__ void p3_ssd_norm(const Frame& F) {
    const bf16_t* Y = (const bf16_t*)(F.ws + WS_YSSD);
    bf16_t* YN = (bf16_t*)(F.ws + WS_YSSDN);
    const float* nw = F.in[I_SSD_NORM];
    const int half = F.lane >> 5, l32 = F.lane & 31;
    for (int it0 = (F.vb * 8 + F.wave) * 16; it0 < T * NGRP; it0 += F.G * 8 * 16) {
        u32x4 w[8]; float ss[8];
#pragma unroll
        for (int q = 0; q < 8; ++q) { const int it = it0 + q * 2 + half; w[q] = *(const u32x4*)(Y + (size_t)(it >> 3) * D + (it & 7) * 256 + l32 * 8); }
#pragma unroll
        for (int q = 0; q < 8; ++q) {
            const float v[8] = {bflo(w[q].x), bfhi(w[q].x), bflo(w[q].y), bfhi(w[q].y), bflo(w[q].z), bfhi(w[q].z), bflo(w[q].w), bfhi(w[q].w)};
            float a = 0.f;
#pragma unroll
            for (int j = 0; j < 8; ++j) a += v[j] * v[j];
            ss[q] = a;
        }
#pragma unroll
        for (int o = 16; o > 0; o >>= 1) {
#pragma unroll
            for (int q = 0; q < 8; ++q) ss[q] += __shfl_xor(ss[q], o);
        }
#pragma unroll
        for (int q = 0; q < 8; ++q) {
            const int it = it0 + q * 2 + half, g = it & 7;
            const float rstd = rsqrtf(ss[q] * (1.0f / 256.0f) + EPS);
            const f32x4 g0 = *(const f32x4*)(nw + g * 256 + l32 * 8), g1 = *(const f32x4*)(nw + g * 256 + l32 * 8 + 4);
            u32x4 o;
            o.x = cvt_pk_bf16(bflo(w[q].x) * rstd * g0[0], bfhi(w[q].x) * rstd * g0[1]); o.y = cvt_pk_bf16(bflo(w[q].y) * rstd * g0[2], bfhi(w[q].y) * rstd * g0[3]);
            o.z = cvt_pk_bf16(bflo(w[q].z) * rstd * g1[0], bfhi(w[q].z) * rstd * g1[1]); o.w = cvt_pk_bf16(bflo(w[q].w) * rstd * g1[2], bfhi(w[q].w) * rstd * g1[3]);
            *(u32x4*)(YN + (size_t)(it >> 3) * D + g * 256 + l32 * 8) = o;
        }
    }
}

__device__ void p4_lru_scan(const Frame& F) {
    const bf16_t* LA = (const bf16_t*)(F.ws + WS_LOGA);
    const bf16_t* LU = (const bf16_t*)(F.ws + WS_LU);
    const bf16_t* P = (const bf16_t*)(F.ws + WS_PROJ);
    bf16_t* YL = (bf16_t*)(F.ws + WS_YLRU);
    LAS float* sP = (LAS float*)F.lds;
    LAS float* sH = sP + 4096;
    const int cgp = F.tid & 7, seg = F.tid >> 3;
    const int t_lo = seg == 0 ? 0 : NMETA + 32 * seg, t_hi = NMETA + 32 + 32 * seg;
    for (int unit = F.vb; unit < NBATCH * 32; unit += F.G) {
        const int b = unit >> 5, ch0 = (unit & 31) * 64 + cgp * 8;
        float Hh[8], Pp[8];
#pragma unroll
        for (int j = 0; j < 8; ++j) { Hh[j] = 0.f; Pp[j] = 0.f; }
#pragma unroll 4
        for (int t = t_lo; t < t_hi; ++t) {
            const size_t off = (size_t)seq_row(b, t) * D + ch0;
            const u32x4 aw = *(const u32x4*)(LA + off), uw = *(const u32x4*)(LU + off);
            const float la[8] = {bflo(aw.x), bfhi(aw.x), bflo(aw.y), bfhi(aw.y), bflo(aw.z), bfhi(aw.z), bflo(aw.w), bfhi(aw.w)};
            const float uu[8] = {bflo(uw.x), bfhi(uw.x), bflo(uw.y), bfhi(uw.y), bflo(uw.z), bfhi(uw.z), bflo(uw.w), bfhi(uw.w)};
#pragma unroll
            for (int j = 0; j < 8; ++j) { Hh[j] = __expf(la[j]) * Hh[j] + uu[j]; Pp[j] += la[j]; }
        }
#pragma unroll
        for (int j = 0; j < 8; ++j) { sP[seg * 64 + cgp * 8 + j] = Pp[j]; sH[seg * 64 + cgp * 8 + j] = Hh[j]; }
        __syncthreads();
        if (F.tid < 64) {
            float car = 0.f;
            for (int s2 = 0; s2 < 64; ++s2) { const float pp = sP[s2 * 64 + F.tid], hh = sH[s2 * 64 + F.tid]; sH[s2 * 64 + F.tid] = car; car = __expf(pp) * car + hh; }
        }
        __syncthreads();
#pragma unroll
        for (int j = 0; j < 8; ++j) Hh[j] = sH[seg * 64 + cgp * 8 + j];
        int t = t_lo;
        for (; t < NMETA && t < t_hi; ++t) {
            const size_t off = (size_t)seq_row(b, t) * D + ch0;
            const u32x4 aw = *(const u32x4*)(LA + off), uw = *(const u32x4*)(LU + off);
            const float la[8] = {bflo(aw.x), bfhi(aw.x), bflo(aw.y), bfhi(aw.y), bflo(aw.z), bfhi(aw.z), bflo(aw.w), bfhi(aw.w)};
            const float uu[8] = {bflo(uw.x), bfhi(uw.x), bflo(uw.y), bfhi(uw.y), bflo(uw.z), bfhi(uw.z), bflo(uw.w), bfhi(uw.w)};
#pragma unroll
            for (int j = 0; j < 8; ++j) Hh[j] = __expf(la[j]) * Hh[j] + uu[j];
        }
#pragma unroll 4
        for (; t < t_hi; ++t) {
            const int row = b * SEQ + (t - NMETA);
            const size_t off = (size_t)row * D + ch0;
            const u32x4 aw = *(const u32x4*)(LA + off), uw = *(const u32x4*)(LU + off), gw = *(const u32x4*)(P + (size_t)row * NP + OLY + ch0);
            const float la[8] = {bflo(aw.x), bfhi(aw.x), bflo(aw.y), bfhi(aw.y), bflo(aw.z), bfhi(aw.z), bflo(aw.w), bfhi(aw.w)};
            const float uu[8] = {bflo(uw.x), bfhi(uw.x), bflo(uw.y), bfhi(uw.y), bflo(uw.z), bfhi(uw.z), bflo(uw.w), bfhi(uw.w)};
#pragma unroll
            for (int j = 0; j < 8; ++j) Hh[j] = __expf(la[j]) * Hh[j] + uu[j];
            u32x4 w; w.x = cvt_pk_bf16(Hh[0] * bflo(gw.x), Hh[1] * bfhi(gw.x)); w.y = cvt_pk_bf16(Hh[2] * bflo(gw.y), Hh[3] * bfhi(gw.y));
            w.z = cvt_pk_bf16(Hh[4] * bflo(gw.z), Hh[5] * bfhi(gw.z)); w.w = cvt_pk_bf16(Hh[6] * bflo(gw.w), Hh[7] * bfhi(gw.w));
            *(u32x4*)(YL + off) = w;
        }
        __syncthreads();
    }
}

__device__ void p7_router(const Frame& F) {
    const float* H1 = (const float*)(F.ws + WS_H1);
    bf16_t* U2 = (bf16_t*)(F.ws + WS_U2);
    const float* g = F.in[I_NORM_FFN];
    const bf16_t* WH = (const bf16_t*)(F.ws + WS_WRH); const bf16_t* WL = (const bf16_t*)(F.ws + WS_WRL);
    unsigned* cnt = (unsigned*)(F.ws + WS_CTL) + CW_CNT;
    int* list = (int*)(F.ws + WS_LIST); float* gate = (float*)(F.ws + WS_GATE);
    LAS float* rs = (LAS float*)F.lds;
    LAS float* part = rs + 64;
    LAS int* hc = (LAS int*)(F.lds + LDS_WORK - 1024);
    LAS int* hb = hc + 64;
    const int lane = F.lane, r = lane & 31, h = lane >> 5;
    LAS float* gl = (LAS float*)(F.lds + 104 * 1024);
    for (int i = F.tid; i < D / 4; i += NTHREADS) *(LAS f32x4*)(gl + 4 * i) = *(const f32x4*)(g + 4 * i);
    __syncthreads();
    for (int tile = F.vb; tile < T / 64; tile += F.G) {
        const int row0 = tile * 64;
        {
            constexpr int RSK = 272;
            LAS unsigned char* Lb = (LAS unsigned char*)part;
            LAS unsigned char* AH = Lb, *AL = AH + 64 * RSK, *BH = AL + 64 * RSK, *BL = BH + 96 * RSK;
            const int mt = F.wave & 1, ks = F.wave >> 1;
            const int arow = F.tid >> 3, aseg = F.tid & 7;
            float ssq = 0.f;
            bf16_t* udst = U2 + (size_t)(row0 + arow) * D + aseg * 16;
            const float* asrc = H1 + (size_t)(row0 + arow) * D + aseg * 16;
            const float* gsrc = g + aseg * 16;
            f32x16 acc[3];
#pragma unroll
            for (int nt = 0; nt < 3; ++nt)
#pragma unroll
                for (int j = 0; j < 16; ++j) acc[nt][j] = 0.f;
#define P7_LDA(c, RA) do { _Pragma("unroll") for (int i = 0; i < 4; ++i) RA[i] = *(const f32x4*)(asrc + (c) * 128 + 4 * i); } while (0)
#define P7_LDB(c) do { _Pragma("unroll") for (int i = 0; i < 3; ++i) { const int pc = F.tid + 512 * i, br = pc >> 4, bs = pc & 15; rbh[i] = *(const u32x4*)(WH + (size_t)br * D + (c) * 128 + bs * 8); rbl[i] = *(const u32x4*)(WL + (size_t)br * D + (c) * 128 + bs * 8); } } while (0)
#define P7_STEP(c, RA) do { \
                _Pragma("unroll") for (int i = 0; i < 2; ++i) { \
                    const f32x4 g0 = *(const LAS f32x4*)(gl + (c) * 128 + aseg * 16 + 8 * i), g1 = *(const LAS f32x4*)(gl + (c) * 128 + aseg * 16 + 8 * i + 4); \
                    float v[8]; \
                    _Pragma("unroll") for (int j = 0; j < 4; ++j) { v[j] = RA[2 * i][j] * g0[j]; v[4 + j] = RA[2 * i + 1][j] * g1[j]; ssq += RA[2 * i][j] * RA[2 * i][j] + RA[2 * i + 1][j] * RA[2 * i + 1][j]; } \
                    u32x4 hw, lw; \
                    hw.x = cvt_pk_bf16(v[0], v[1]); hw.y = cvt_pk_bf16(v[2], v[3]); hw.z = cvt_pk_bf16(v[4], v[5]); hw.w = cvt_pk_bf16(v[6], v[7]); \
                    lw.x = cvt_pk_bf16(v[0] - bflo(hw.x), v[1] - bfhi(hw.x)); lw.y = cvt_pk_bf16(v[2] - bflo(hw.y), v[3] - bfhi(hw.y)); \
                    lw.z = cvt_pk_bf16(v[4] - bflo(hw.z), v[5] - bfhi(hw.z)); lw.w = cvt_pk_bf16(v[6] - bflo(hw.w), v[7] - bfhi(hw.w)); \
                    *(LAS u32x4*)(AH + arow * RSK + aseg * 32 + i * 16) = hw; *(LAS u32x4*)(AL + arow * RSK + aseg * 32 + i * 16) = lw; \
                    *(u32x4*)(udst + (c) * 128 + i * 8) = hw;   \
                } \
                _Pragma("unroll") for (int i = 0; i < 3; ++i) { const int pc = F.tid + 512 * i, br = pc >> 4, bs = pc & 15; *(LAS u32x4*)(BH + br * RSK + bs * 16) = rbh[i]; *(LAS u32x4*)(BL + br * RSK + bs * 16) = rbl[i]; } \
                __syncthreads(); \
                if ((c) + 1 < 16) P7_LDB((c) + 1);      \
                if ((c) + 2 < 16) P7_LDA((c) + 2, RA);   \
                _Pragma("unroll") for (int kk = 0; kk < 2; ++kk) { \
                    const int ko = (ks * 2 + kk) * 32 + h * 16; \
                    const bf16x8 ah = *(const LAS bf16x8*)(AH + (mt * 32 + r) * RSK + ko), al = *(const LAS bf16x8*)(AL + (mt * 32 + r) * RSK + ko); \
                    _Pragma("unroll") for (int nt = 0; nt < 3; ++nt) { \
                        const bf16x8 bhv = *(const LAS bf16x8*)(BH + (nt * 32 + r) * RSK + ko), blv = *(const LAS bf16x8*)(BL + (nt * 32 + r) * RSK + ko); \
                        acc[nt] = __builtin_amdgcn_mfma_f32_32x32x16_bf16(ah, bhv, acc[nt], 0, 0, 0); \
                        acc[nt] = __builtin_amdgcn_mfma_f32_32x32x16_bf16(al, bhv, acc[nt], 0, 0, 0); \
                        acc[nt] = __builtin_amdgcn_mfma_f32_32x32x16_bf16(ah, blv, acc[nt], 0, 0, 0); \
                    } \
                } \
                __syncthreads(); } while (0)
            f32x4 ra0[4], ra1[4]; u32x4 rbh[3], rbl[3];
            P7_LDA(0, ra0); P7_LDB(0); P7_LDA(1, ra1);
#pragma unroll 1
            for (int c = 0; c < 16; c += 2) { P7_STEP(c, ra0); P7_STEP(c + 1, ra1); }
#undef P7_LDA
#undef P7_LDB
#undef P7_STEP
#pragma unroll
            for (int nt = 0; nt < 3; ++nt)
#pragma unroll
                for (int j = 0; j < 16; ++j) { const int tok = mt * 32 + (j & 3) + 8 * (j >> 2) + 4 * h; part[(ks * 64 + tok) * 97 + nt * 32 + r] = acc[nt][j]; }
            ssq += __shfl_xor(ssq, 1); ssq += __shfl_xor(ssq, 2); ssq += __shfl_xor(ssq, 4);
            if (aseg == 0) { const float rstd = rsqrtf(ssq * (1.0f / D) + EPS); rs[arow] = rstd; ((float*)(F.ws + WS_RSTD))[row0 + arow] = rstd; }
        }
        __syncthreads();
        if (F.tid < 64) {
            const LAS float* p0 = part + F.tid * 97;
            const float rsv = rs[F.tid];
            float l[8];
#pragma unroll
            for (int j = 0; j < 8; ++j) l[j] = rsv * ((p0[j] + p0[64 * 97 + j]) + (p0[128 * 97 + j] + p0[192 * 97 + j]));
            int gi = 0; float gm = l[0];
#pragma unroll
            for (int j = 1; j < 8; ++j) if (l[j] > gm) { gm = l[j]; gi = j; }
            float gs = 0.f;
#pragma unroll
            for (int j = 0; j < 8; ++j) gs += __expf(l[j] - gm);
            const float gp = 1.0f / gs;
            float el[8];
#pragma unroll
            for (int j = 0; j < 8; ++j) { const int n = 8 + gi * 8 + j; el[j] = rsv * ((p0[n] + p0[64 * 97 + n]) + (p0[128 * 97 + n] + p0[192 * 97 + n])); }
            int i0 = 0; float m0 = el[0];
#pragma unroll
            for (int j = 1; j < 8; ++j) if (el[j] > m0) { m0 = el[j]; i0 = j; }
            int i1 = -1; float m1 = -3.0e38f;
#pragma unroll
            for (int j = 0; j < 8; ++j) if (j != i0 && el[j] > m1) { m1 = el[j]; i1 = j; }
            const float r1 = __expf(m1 - m0), w0 = 1.0f / (1.0f + r1), w1 = r1 * w0;
            const int tokg = row0 + F.tid;
            const int e0 = gi * 8 + i0, e1 = gi * 8 + i1;
            gate[tokg * 2] = gp * w0; gate[tokg * 2 + 1] = gp * w1;
            hc[F.tid] = 0;
            asm volatile("s_waitcnt lgkmcnt(0)" ::: "memory");
            const int lk0 = __hip_atomic_fetch_add(hc + e0, 1, __ATOMIC_RELAXED, __HIP_MEMORY_SCOPE_WORKGROUP);
            const int lk1 = __hip_atomic_fetch_add(hc + e1, 1, __ATOMIC_RELAXED, __HIP_MEMORY_SCOPE_WORKGROUP);
            asm volatile("s_waitcnt lgkmcnt(0)" ::: "memory");
            const int mine = hc[F.tid];
            unsigned basee = 0u;
            if (mine > 0) basee = atomicAdd(&cnt[F.tid], (unsigned)mine);
            hb[F.tid] = (int)basee;
            asm volatile("s_waitcnt lgkmcnt(0)" ::: "memory");
            list[(size_t)e0 * T + hb[e0] + lk0] = tokg * 2; list[(size_t)e1 * T + hb[e1] + lk1] = tokg * 2 + 1;
        }
        __syncthreads();
    }
}

__device__ void moe_tables(const Frame& F, int nN, LAS int* ub, LAS int* tb, LAS int* cl) {
    const unsigned* cnt = (const unsigned*)(F.ws + WS_CTL) + CW_CNT;
    LAS int* us = cl + 80;
    if (F.tid < 64) {
        const int ce = (int)cnt[F.tid]; cl[F.tid] = ce;
        const int mt = (ce + 255) >> 8;
        const int ns = (mt > 0 && ce - ((mt - 1) << 8) <= 128) ? 1 : 0, nl = mt - ns;
        int incl = mt, incL = nl, incS = ns;
#pragma unroll
        for (int o = 1; o < 64; o <<= 1) { const int v = __shfl_up(incl, o), vL = __shfl_up(incL, o), vS = __shfl_up(incS, o); if (F.lane >= o) { incl += v; incL += vL; incS += vS; } }
        tb[F.tid] = incl - mt; ub[F.tid] = (incL - nl) * nN; us[F.tid] = (incS - ns) * nN;
        if (F.tid == 63) { tb[NEXP] = incl; ub[NEXP] = incL * nN; us[NEXP] = incS * nN; }
    }
    __syncthreads();
}

__device__ void p10_final(const Frame& F) {
    const float* H1 = (const float*)(F.ws + WS_H1);
    const bf16_t* Y = (const bf16_t*)(F.ws + WS_Y);
    const float* g = F.in[I_NORM_FINAL];
    for (int row = F.vb * 8 + F.wave; row < T; row += F.G * 8) {
        f32x4 v[8]; float ss = 0.f;
#pragma unroll
        for (int i = 0; i < 8; ++i) {
            const int col = i * 256 + F.lane * 4;
            v[i] = *(const f32x4*)(H1 + (size_t)row * D + col);
            const u32x2 a = *(const u32x2*)(Y + (size_t)(row * 2) * D + col), b = *(const u32x2*)(Y + (size_t)(row * 2 + 1) * D + col);
            v[i][0] += bflo(a.x) + bflo(b.x); v[i][1] += bfhi(a.x) + bfhi(b.x); v[i][2] += bflo(a.y) + bflo(b.y); v[i][3] += bfhi(a.y) + bfhi(b.y);
            ss += v[i][0] * v[i][0] + v[i][1] * v[i][1] + v[i][2] * v[i][2] + v[i][3] * v[i][3];
        }
        ss = wave_sum(ss);
        const float rstd = rsqrtf(ss * (1.0f / D) + EPS);
#pragma unroll
        for (int i = 0; i < 8; ++i) {
            const int col = i * 256 + F.lane * 4;
            const f32x4 gg = *(const f32x4*)(g + col);
            f32x4 o; o[0] = v[i][0] * rstd * gg[0]; o[1] = v[i][1] * rstd * gg[1]; o[2] = v[i][2] * rstd * gg[2]; o[3] = v[i][3] * rstd * gg[3];
            *(f32x4*)(F.out + (size_t)row * D + col) = o;
        }
    }
}


typedef __attribute__((address_space(4))) const Args* KArgsPtr;
__device__ __forceinline__ Frame refresh(const Frame& F0) {
    Frame F = F0;
    int t = threadIdx.x; asm volatile("" : "+v"(t));
    F.tid = t; F.lane = t & 63; F.wave = __builtin_amdgcn_readfirstlane(t >> 6);
    KArgsPtr ap = (KArgsPtr)__builtin_amdgcn_kernarg_segment_ptr(); asm volatile("" : "+s"(ap));
#pragma unroll
    for (int i = 0; i < 28; ++i) F.in[i] = ap->in[i];
    F.out = ap->out; F.ws = ap->ws;
    return F;
}
__device__ __forceinline__ void ph1(const Frame& F) {
    pg8::DenseSched S; S.init(F.ws + WS_U, D * 2, F.ws + WS_WIN, D, T / 256, NP / 256, F.G, F.vb);
    EpiProj E{(bf16_t*)(F.ws + WS_PROJ), F.in[I_GATE_BIAS]};
    pg8::gemm_phase<EpiProj, pg8::DenseSched, false>(F.lds, D, S, E);
    p1_thin(F);
}
__device__ __forceinline__ void ph3(const Frame& F) {
    p2_ssd_chunk(F);
    pg8::DenseSched S; S.init(F.ws + WS_XR, D * 2, F.ws + WS_WLRU, 256, 64, 16, F.G, F.vb, 512);
    EpiLru E{(const bf16_t*)(F.ws + WS_XR), (bf16_t*)(F.ws + WS_LOGA), (bf16_t*)(F.ws + WS_LU), F.in[I_LRU_BA], F.in[I_LRU_BX], F.in[I_LRU_LAMBDA]};
    pg8::gemm_phase<EpiLru, pg8::DenseSched, false>(F.lds, 256, S, E);
    p3_lru_meta(F);
}
__device__ __forceinline__ void ph4(const Frame& F) { p4_lru_scan(F); p3_ssd_norm(F); }
__device__ __forceinline__ void ph5(const Frame& F) {
    pg8::PairSched S; S.init(F.ws + WS_YSSDN, F.ws + WS_YLRU, D * 2, F.ws + WS_WSO, F.ws + WS_WLO, D, T / 256, D / 256, F.G, F.vb);
    EpiMixPair E{(const bf16_t*)(F.ws + WS_PROJ), (bf16_t*)(F.ws + WS_MIXED)};
    pg8::gemm_phase<EpiMixPair, pg8::PairSched, false, false, true>(F.lds, D, S, E);
}
__device__ __forceinline__ void ph6(const Frame& F) {
    pg8::DenseSched S; S.init(F.ws + WS_MIXED, D * 2, F.ws + WS_WOUT, D, T / 256, D / 256, F.G, F.vb);
    EpiRes E{F.in[I_X], (float*)(F.ws + WS_H1)};
    pg8::gemm_phase<EpiRes, pg8::DenseSched, false>(F.lds, D, S, E);
}
__device__ __forceinline__ void ph8(const Frame& F) {
    LAS int* ub = (LAS int*)(F.lds + MISC_OFF + 256); LAS int* tb = ub + 80; LAS int* cl = tb + 80;
    moe_tables(F, FF / 128, ub, tb, cl);
    pg8::MoeSched S; S.A = (const char*)(F.ws + WS_U2); S.W0 = (const char*)F.in[I_W_EG]; S.W1 = (const char*)F.in[I_W_EU]; S.list = (const int*)(F.ws + WS_LIST); S.ub = ub; S.us = cl + 80; S.tb = tb; S.cl = cl;
    S.rowval = (const float*)(F.ws + WS_RSTD); S.valshift = 1; S.rowtbl = F.lds + MOE_ROWTBL_OFF;
    S.lda = D * 2; S.K = D; S.nN = FF / 128; S.G = F.G; S.c = F.vb; S.gather = 1; S.ldb = FF * 4; S.cpn = 128 * 4; S.bstride = (size_t)D * FF * 4;
    EpiMoe1 E{(bf16_t*)(F.ws + WS_HDN), F.lds + MOE_ROWTBL_OFF};
    pg8::gemm_phase<EpiMoe1, pg8::MoeSched, true, true, false, true, true>(F.lds, D, S, E);
}
__device__ __forceinline__ void ph9(const Frame& F) {
    LAS int* ub = (LAS int*)(F.lds + MISC_OFF + 256); LAS int* tb = ub + 80; LAS int* cl = tb + 80;
    static_assert(FF / 128 == D / 256, "the MoE down phase reuses the unit tables of the MoE up phase");
#if MK_N_LAUNCHES != 1
    moe_tables(F, D / 256, ub, tb, cl);
#endif
    pg8::MoeSched S; S.A = (const char*)(F.ws + WS_HDN); S.W0 = (const char*)(F.ws + WS_W2); S.W1 = S.W0; S.list = (const int*)(F.ws + WS_LIST); S.ub = ub; S.us = cl + 80; S.tb = tb; S.cl = cl;
    S.rowval = (const float*)(F.ws + WS_GATE); S.valshift = 0; S.rowtbl = F.lds + MOE_ROWTBL_OFF;
    S.lda = FF * 2; S.K = FF; S.nN = D / 256; S.G = F.G; S.c = F.vb; S.gather = 0; S.ldb = 0; S.cpn = 256 * FF * 2; S.bstride = (size_t)D * FF * 2;
    EpiMoe2 E{(bf16_t*)(F.ws + WS_Y), F.lds + MOE_ROWTBL_OFF};
    pg8::gemm_phase<EpiMoe2, pg8::MoeSched, false, false, false, true, true>(F.lds, FF, S, E);
}

constexpr int N_PHASES = 11;
__global__ void __launch_bounds__(NTHREADS, 2) fwd(Args args) {
    extern __shared__ __attribute__((aligned(16))) unsigned char lds_raw[];
    Frame F0;
    F0.lds = (LAS unsigned char*)lds_raw;
    F0.tid = threadIdx.x; F0.lane = F0.tid & 63; F0.wave = __builtin_amdgcn_readfirstlane(F0.tid >> 6);
    F0.G = gridDim.x; F0.vb = blockIdx.x;
#pragma unroll
    for (int i = 0; i < 28; ++i) F0.in[i] = args.in[i];
    F0.out = args.out; F0.ws = args.ws;
    volatile LAS unsigned* MISC = (volatile LAS unsigned*)(F0.lds + MISC_OFF);
    if (threadIdx.x < 4) MISC[threadIdx.x] = 0u;
    __syncthreads();
    const int lo = args.ph_lo, hi = args.ph_hi;
    XcdBarrier bar; bar.bar = (unsigned*)(args.ws + WS_CTL) + CW_BAR; bar.x = 0; bar.st = MISC;
    if (hi - lo > 1) bar = xcd_barrier_post((unsigned*)(args.ws + WS_CTL) + CW_BAR, MISC);
#ifndef PHMASK
#define PHMASK 0x7ff
#endif
#define IN(k) (((PHMASK >> (k)) & 1) && lo <= (k) && (k) < hi)
#define SEAM(k) do { if (IN(k) && IN((k) + 1)) xcd_barrier(bar); } while (0)
#ifndef REPMASK
#define REPMASK 0
#endif

#define RUN(k, call) do { if (IN(k)) { { const Frame F = refresh(F0); call; } if ((REPMASK >> (k)) & 1) { const Frame F = refresh(F0); call; } } } while (0)
    RUN(0, p0_prologue(F));
    SEAM(0);
    RUN(1, ph1(F));
    SEAM(1);
    RUN(2, p2_conv(F));
    SEAM(2);
    RUN(3, ph3(F));
    SEAM(3);
    RUN(4, ph4(F));
    SEAM(4);
    RUN(5, ph5(F));
    SEAM(5);
    RUN(6, ph6(F));
    SEAM(6);
    RUN(7, p7_router(F));
    SEAM(7);
    RUN(8, ph8(F));
    SEAM(8);
    RUN(9, ph9(F));
    SEAM(9);
    RUN(10, p10_final(F));
#undef IN
#undef SEAM
}

extern "C" void kernel_launch(void* const* d_in, const int* in_sizes, int n_in, void* d_out, int out_size, void* d_ws, size_t ws_size, hipStream_t stream) {
    static int grid = 0;
    if (grid == 0) {
        if (n_in != 28 || ws_size < WS_END) { fprintf(stderr, "kernel_launch: unexpected n_in %d / ws_size %zu (need %zu)\n", n_in, ws_size, (size_t)WS_END); grid = -1; return; }
        int dev = 0, cus = 0, per_cu = 0;
        if (hipGetDevice(&dev) != hipSuccess || hipDeviceGetAttribute(&cus, hipDeviceAttributeMultiprocessorCount, dev) != hipSuccess) { grid = -1; return; }
        if (hipFuncSetAttribute((const void*)fwd, hipFuncAttributeMaxDynamicSharedMemorySize, LDS_BYTES) != hipSuccess) { fprintf(stderr, "kernel_launch: hipFuncSetAttribute failed\n"); grid = -1; return; }
        if (hipOccupancyMaxActiveBlocksPerMultiprocessor(&per_cu, (const void*)fwd, NTHREADS, LDS_BYTES) != hipSuccess || per_cu < 1) { fprintf(stderr, "kernel_launch: occupancy query says %d\n", per_cu); }
        (void)hipGetLastError();
        grid = cus;
    }
    if (grid < 0) return;
    (void)hipMemsetAsync((char*)d_ws + WS_CTL, 0, CTL_BYTES, stream);
    Args a; memset(&a, 0, sizeof(a));
    for (int i = 0; i < 28; ++i) a.in[i] = (const float*)d_in[i];
    a.out = (float*)d_out; a.ws = (unsigned char*)d_ws;
#if MK_N_LAUNCHES == 1
    a.ph_lo = 0; a.ph_hi = N_PHASES;
    hipLaunchKernelGGL(fwd, dim3(grid), dim3(NTHREADS), LDS_BYTES, stream, a);
#else
    for (int p = 0; p < N_PHASES; ++p) { a.ph_lo = p; a.ph_hi = p + 1; hipLaunchKernelGGL(fwd, dim3(grid), dim3(NTHREADS), LDS_BYTES, stream, a); }
#endif
}
```

```cpp
#include <hip/hip_runtime.h>
#include <stdint.h>
#include <string.h>
#include <stdio.h>

#ifndef MK_N_LAUNCHES
#define MK_N_LAUNCHES 1
#endif

#define LAS __attribute__((address_space(3)))
typedef unsigned short bf16_t;
typedef short bf16x8 __attribute__((ext_vector_type(8)));
typedef float f32x4 __attribute__((ext_vector_type(4)));
typedef float f32x2 __attribute__((ext_vector_type(2)));
typedef float f32x16 __attribute__((ext_vector_type(16)));
typedef unsigned u32x4 __attribute__((ext_vector_type(4)));
typedef unsigned u32x2 __attribute__((ext_vector_type(2)));

constexpr int D = 2048, NBATCH = 8, SEQ = 2048, NMETA = 16;
constexpr int T = NBATCH * SEQ;
constexpr int TR = T + NMETA;
constexpr int TRP = 65 * 256;
constexpr int NP = 14336;
constexpr int OZ = 0, OXBC = 2048, OLX = 6144, OLY = 8192, OGL = 10240;
constexpr int NHEAD = 32, HD = 64, NGRP = 8, NST = 128;
constexpr int NEXP = 64, FF = 1024;
constexpr float EPS = 1e-6f;
constexpr int NTHREADS = 512;

constexpr size_t MiB = 1024 * 1024;
constexpr size_t WS_CTL = 0;
constexpr size_t CTL_BYTES = 64 * 1024;
constexpr size_t CW_BAR = 0;
constexpr size_t CW_CNT = 4096;
constexpr size_t WS_LIST = 1 * MiB;
constexpr size_t WS_GATE = WS_LIST + 4 * MiB;
constexpr size_t WS_RSTD = WS_GATE + 128 * 1024;
constexpr size_t WS_WRH = WS_GATE + 256 * 1024;
constexpr size_t WS_WRL = WS_GATE + 640 * 1024;
constexpr size_t WS_DT = WS_GATE + 1 * MiB;
constexpr size_t WS_WIN = WS_DT + 3 * MiB;
constexpr size_t WS_WSO = WS_WIN + 57 * MiB;
constexpr size_t WS_WLO = WS_WSO + 8 * MiB;
constexpr size_t WS_WOUT = WS_WLO + 8 * MiB;
constexpr size_t WS_WLRU = WS_WOUT + 8 * MiB;
constexpr size_t WS_W13 = WS_WLRU + 2 * MiB;
constexpr size_t WS_W2 = WS_W13 + 512 * MiB;
constexpr size_t WS_U = WS_W2 + 256 * MiB;
constexpr size_t WS_XR = WS_U + 65 * MiB;
constexpr size_t WS_LOGA = WS_XR + 65 * MiB;
constexpr size_t WS_LU = WS_LOGA + 65 * MiB;
constexpr size_t WS_YSSD = WS_LU + 65 * MiB;
constexpr size_t WS_YSSDN = WS_YSSD + 64 * MiB;
constexpr size_t WS_YLRU = WS_YSSDN + 64 * MiB;
constexpr size_t WS_PROJ = WS_YLRU + 64 * MiB;
constexpr size_t WS_XBCS = WS_PROJ + 455 * MiB;
constexpr size_t WS_END = WS_XBCS + 130 * MiB;
constexpr size_t WS_T1 = WS_U;
constexpr size_t WS_MIXED = WS_LOGA;
constexpr size_t WS_H1 = WS_LU;
constexpr size_t WS_U2 = WS_YSSDN;
constexpr size_t WS_HDN = WS_PROJ;
constexpr size_t WS_Y = WS_PROJ + 96 * MiB;
static_assert(WS_END <= 2048 * MiB, "workspace");
static_assert((size_t)14368 * 2048 * 2 <= 57 * MiB && (size_t)TRP * 2048 * 2 <= 65 * MiB && (size_t)TRP * NP * 2 <= 455 * MiB, "sizes");

typedef __bf16 bf16x2_t __attribute__((ext_vector_type(2)));
__device__ __forceinline__ unsigned cvt_pk_bf16(float lo, float hi) { const f32x2 v = {lo, hi}; const bf16x2_t b = __builtin_convertvector(v, bf16x2_t); return __builtin_bit_cast(unsigned, b); }
__device__ __forceinline__ unsigned short f2bf(float v) { return (unsigned short)(cvt_pk_bf16(v, 0.f) & 0xffffu); }
__device__ __forceinline__ float bf2f(unsigned short b) { return __uint_as_float(((unsigned)b) << 16); }
__device__ __forceinline__ float bflo(unsigned w) { return __uint_as_float(w << 16); }
__device__ __forceinline__ float bfhi(unsigned w) { return __uint_as_float(w & 0xffff0000u); }
__device__ __forceinline__ float sigmoidf_(float x) { return __builtin_amdgcn_rcpf(1.0f + __expf(-x)); }
__device__ __forceinline__ float siluf_(float x) { return x * __builtin_amdgcn_rcpf(1.0f + __expf(-x)); }
__device__ __forceinline__ float gelu_tanh_(float x) { const float y = 1.5957691216f * (x + 0.044715f * x * x * x); return x * __builtin_amdgcn_rcpf(1.0f + __expf(-y)); }
__device__ __forceinline__ float softplusf_(float x) { return fmaxf(x, 0.0f) + __logf(1.0f + __expf(-fabsf(x))); }
__device__ __forceinline__ float wave_sum(float v) {
#pragma unroll
    for (int o = 32; o > 0; o >>= 1) v += __shfl_xor(v, o);
    return v;
}

#define XB_TMO      128
#define XB_XCNT(j)  (256  + 64 * (j))
#define XB_XSUB(j)  (1280 + 64 * (j))
#define XB_XGEN(j)  (2304 + 64 * (j))
#define XB_TOP      3328
#define XB_TOPGEN   3392
#define XCD_BAR_WORDS 3456
#define XB_SPIN_CAP (1u << 22)

__device__ __forceinline__ unsigned xb_ld(unsigned* p)              { return __hip_atomic_load(p, __ATOMIC_RELAXED, __HIP_MEMORY_SCOPE_AGENT); }
__device__ __forceinline__ unsigned xb_add(unsigned* p, unsigned v) { return __hip_atomic_fetch_add(p, v, __ATOMIC_RELAXED, __HIP_MEMORY_SCOPE_AGENT); }
__device__ __forceinline__ unsigned xb_xcc_id() { return (unsigned)__builtin_amdgcn_s_getreg((3 << 11) | 20) & 0xFu; }
#define XB_SPIN(cond, bar) do { unsigned _sp = 0; while (cond) { __builtin_amdgcn_s_sleep(1); \
    if ((++_sp & 255u) == 0u) { if (xb_ld(&(bar)[XB_TMO])) break; if (_sp > XB_SPIN_CAP) { atomicAdd(&(bar)[XB_TMO], 1u); break; } } } } while (0)

struct XcdBarrier { unsigned* bar; unsigned x; volatile LAS unsigned* st; };

__device__ __forceinline__ XcdBarrier xcd_barrier_post(unsigned* bar, volatile LAS unsigned* st) {
    XcdBarrier b; b.bar = bar; b.x = xb_xcc_id(); b.st = st;
    if (threadIdx.x == 0) (void)xb_add(&bar[XB_XCNT(b.x)], 1u);
    return b;
}
__device__ __forceinline__ void xcd_barrier_complete(unsigned* bar, unsigned x, unsigned& nloc, unsigned& nx) {
    const unsigned G = gridDim.x * gridDim.y * gridDim.z;
    unsigned sum, cnt, mine, sp = 0u;
    for (;;) {
        sum = 0u; cnt = 0u; mine = 0u;
#pragma unroll
        for (unsigned j = 0; j < 16; ++j) { const unsigned c = xb_ld(&bar[XB_XCNT(j)]); sum += c; cnt += (c > 0u) ? 1u : 0u; mine = (j == x) ? c : mine; }
        if (sum == G) break;
        __builtin_amdgcn_s_sleep(1);
        if ((++sp & 255u) == 0u) { if (xb_ld(&bar[XB_TMO])) break; if (sp > XB_SPIN_CAP) { atomicAdd(&bar[XB_TMO], 1u); break; } }
    }
    nloc = mine > 0u ? mine : 1u; nx = cnt > 0u ? cnt : 1u;
}
__device__ __forceinline__ void xcd_barrier(const XcdBarrier& b) {
    asm volatile("s_waitcnt vmcnt(0)" ::: "memory");
    __syncthreads();
    if (threadIdx.x == 0) {
        unsigned* bar = b.bar;
        __builtin_amdgcn_s_waitcnt(0);
        unsigned nloc = b.st[0], nx = b.st[1];
        if (nloc == 0u) { xcd_barrier_complete(bar, b.x, nloc, nx); b.st[0] = nloc; b.st[1] = nx; }
        const unsigned old = xb_add(&bar[XB_XSUB(b.x)], 1u);
        const unsigned gen = old / nloc;
        if (old + 1u == (gen + 1u) * nloc) {
            __builtin_amdgcn_fence(__ATOMIC_RELEASE, "agent");
            asm volatile("s_waitcnt vmcnt(0)" ::: "memory");
            const unsigned og = xb_add(&bar[XB_TOP], 1u);
            const unsigned tg = og / nx;
            if (og + 1u == (tg + 1u) * nx) xb_add(&bar[XB_TOPGEN], 1u);
            else XB_SPIN(xb_ld(&bar[XB_TOPGEN]) == tg, bar);
            __builtin_amdgcn_fence(__ATOMIC_ACQUIRE, "agent");
            xb_add(&bar[XB_XGEN(b.x)], 1u);
            asm volatile("s_waitcnt vmcnt(0)" ::: "memory");
        } else {
            XB_SPIN(xb_ld(&bar[XB_XGEN(b.x)]) == gen, bar);
            __builtin_amdgcn_fence(__ATOMIC_ACQUIRE, "agent");
            asm volatile("s_waitcnt vmcnt(0)" ::: "memory");
        }
    }
    __syncthreads();
}

namespace pg8 {
constexpr int BM = 256, BK = 64, HALF = 128, HTB = HALF * BK * 2, STAGE_BYTES = 8 * HTB, NXCD = 8, WGM = 8;
__host__ __device__ __forceinline__ int lds_byte(int r, int c) { const int st = (r >> 4) * 2 + (c >> 5), rr = r & 15, cc = c & 31, ob = rr * 64 + cc * 2; return st * 1024 + (ob ^ (((ob >> 9) & 1) << 5)); }
__host__ __device__ __forceinline__ void stage_rc(int b, int& R, int& C) { const int st = b >> 10, sb = b & 1023, swz = sb ^ (((sb >> 9) & 1) << 5); R = (st >> 1) * 16 + (swz >> 6); C = (st & 1) * 32 + ((swz & 63) >> 1); }
__host__ __device__ __forceinline__ int perm32(int rho) { const int n = rho >> 4, i = rho & 15; return 8 * (i >> 2) + 4 * n + (i & 3); }

struct Unit { const char* A; const char* B; const char* B1; int pm, pn, e, cnt, par; };

struct DenseSched {
    static constexpr int ldb = 0;
    const char* A; const char* B; int lda  , K, nM, nN, nwg, G, c, acb  ;
    __device__ void init(const void* A_, int lda_bytes, const void* B_, int K_, int nM_, int nN_, int G_, int c_, int acb_ = 0) { A = (const char*)A_; B = (const char*)B_; lda = lda_bytes; K = K_; nM = nM_; nN = nN_; nwg = nM * nN; G = G_; c = c_; acb = acb_; }
    __device__ bool next(int i, Unit& u) const {
        const long L = (long)i * G + c; if (L >= nwg) return false;
        int wgid = (int)L; { const int q = nwg / NXCD, r = nwg % NXCD, xcd = wgid % NXCD, off = wgid / NXCD; wgid = (xcd < r ? xcd * (q + 1) : r * (q + 1) + (xcd - r) * q) + off; }
        const int nig = WGM * nN, gid = wgid / nig, fm = gid * WGM, gsz = (nM - fm) < WGM ? (nM - fm) : WGM;
        u.pm = fm + ((wgid % nig) % gsz); u.pn = (wgid % nig) / gsz; u.e = 0; u.cnt = 256; u.par = 0;
        u.A = A + (size_t)u.pm * 256 * lda + (size_t)(u.pn >> 1) * acb; u.B = B + (size_t)u.pn * 256 * K * 2; u.B1 = u.B;
        return true;
    }
    __device__ __forceinline__ void aoffs(const Unit&, const int (&R)[2], const int (&C)[2], unsigned (&v)[4]) const {
#pragma unroll
        for (int h = 0; h < 2; ++h)
#pragma unroll
            for (int i = 0; i < 2; ++i) v[h * 2 + i] = (unsigned)((R[i] + 128 * h) * lda + C[i] * 2);
    }
};

struct PairSched {
    static constexpr int ldb = 0;
    const char* A0; const char* A1; const char* B0; const char* B1; int lda, K, nM, nN, nwg, G, c;
    __device__ void init(const void* A0_, const void* A1_, int lda_bytes, const void* B0_, const void* B1_, int K_, int nM_, int nN_, int G_, int c_) {
        A0 = (const char*)A0_; A1 = (const char*)A1_; B0 = (const char*)B0_; B1 = (const char*)B1_; lda = lda_bytes; K = K_; nM = nM_; nN = nN_; nwg = nM * nN; G = G_; c = c_; }
    __device__ bool next(int i, Unit& u) const {
        const long L = (long)(i >> 1) * G + c; if (L >= nwg) return false;
        int wgid = (int)L; { const int q = nwg / NXCD, r = nwg % NXCD, xcd = wgid % NXCD, off = wgid / NXCD; wgid = (xcd < r ? xcd * (q + 1) : r * (q + 1) + (xcd - r) * q) + off; }
        const int nig = WGM * nN, gid = wgid / nig, fm = gid * WGM, gsz = (nM - fm) < WGM ? (nM - fm) : WGM;
        u.pm = fm + ((wgid % nig) % gsz); u.pn = (wgid % nig) / gsz; u.e = i & 1; u.cnt = 256; u.par = 0;
        u.A = ((i & 1) ? A1 : A0) + (size_t)u.pm * 256 * lda; u.B = ((i & 1) ? B1 : B0) + (size_t)u.pn * 256 * K * 2; u.B1 = u.B;
        return true;
    }
    __device__ __forceinline__ void aoffs(const Unit&, const int (&R)[2], const int (&C)[2], unsigned (&v)[4]) const {
#pragma unroll
        for (int h = 0; h < 2; ++h)
#pragma unroll
            for (int i = 0; i < 2; ++i) v[h * 2 + i] = (unsigned)((R[i] + 128 * h) * lda + C[i] * 2);
    }
};

struct MoeSched {
    const char* A; const char* W0; const char* W1; const int* list; const float* rowval; LAS const int* ub; LAS const int* us; LAS const int* tb; LAS const int* cl; LAS unsigned char* rowtbl;
    int lda, K, nN, G, c, gather, ldb  , cpn  , valshift  ; size_t bstride  ;
    __device__ bool next(int i, Unit& u) const {
        int p = (G & 7) == 0 ? (c & 7) * (G >> 3) + (c >> 3) : c; if (i & 1) p = G - 1 - p;
        const int L = i * G + p, totL = ub[NEXP]; if (L >= totL + us[NEXP]) return false;
        const bool sh = L >= totL; const LAS int* pre = sh ? us : ub; const int Lq = sh ? L - totL : L;
        int lo = 0, hi = NEXP - 1;
        while (lo < hi) { const int mid = (lo + hi + 1) >> 1; if (pre[mid] <= Lq) lo = mid; else hi = mid - 1; }
        const int e = lo, r = Lq - pre[e], mt = tb[e + 1] - tb[e], nl = mt - (us[e + 1] != us[e] ? 1 : 0);
        u.e = e; u.pn = sh ? r : r / nl; const int m = sh ? mt - 1 : r % nl; u.pm = tb[e] + m; u.par = i & 1;
        const int ce = cl[e]; u.cnt = (ce - m * 256) < 256 ? (ce - m * 256) : 256;
        u.B = W0 + (size_t)e * bstride + (size_t)u.pn * cpn; u.B1 = W1 + (size_t)e * bstride + (size_t)u.pn * cpn;
        u.A = gather ? A : A + (size_t)u.pm * 256 * lda;
        return true;
    }
    __device__ __forceinline__ const int* entry_ptr(const Unit& u, int t) const { return list + (size_t)u.e * T + (u.pm - tb[u.e]) * 256 + (t < u.cnt ? t : 0); }
    __device__ __forceinline__ const float* val_ptr(int entry) const { return rowval + (entry >> valshift); }
    __device__ __forceinline__ LAS int* tbl_ent(int par) const { return (LAS int*)(rowtbl + par * 2048); }
    __device__ __forceinline__ LAS float* tbl_val(int par) const { return (LAS float*)(rowtbl + par * 2048 + 1024); }
    __device__ __forceinline__ void aoffs(const Unit& u, const int (&R)[2], const int (&C)[2], unsigned (&v)[4]) const {
        const LAS int* te = tbl_ent(u.par);
#pragma unroll
        for (int h = 0; h < 2; ++h)
#pragma unroll
            for (int i = 0; i < 2; ++i) {
                const int r = R[i] + 128 * h;
                if (gather) v[h * 2 + i] = (unsigned)(te[r] >> 1) * (unsigned)lda + (unsigned)(C[i] * 2);
                else v[h * 2 + i] = (unsigned)(r * lda + C[i] * 2);
            }
    }
};

template <class Epi, class Sched, bool DYN, bool BF32 = false, bool PAIR = false, bool MSKIP = false, bool TBL = false>
__device__ __forceinline__ void gemm_phase(LAS unsigned char* lds, const int K, const Sched& S, const Epi& E) {
    const int tid = threadIdx.x, wid = __builtin_amdgcn_readfirstlane(tid >> 6), lane = tid & 63, wr = wid >> 2, wc = wid & 3, fr = lane & 15, fq = lane >> 4;
    const int nt = K / BK;
    int Rr[2], Cc[2]; unsigned voffB[2];
#pragma unroll
    for (int i = 0; i < 2; ++i) { stage_rc(tid * 16 + i * 8192, Rr[i], Cc[i]); const int Rb = Epi::PERM ? ((Rr[i] & ~31) + perm32(Rr[i] & 31)) : Rr[i]; voffB[i] = (unsigned)(Rb * K + Cc[i]) * 2u; }
    const size_t kstep = (size_t)(BK * 2);
    const size_t hstepB = (size_t)HALF * K * 2;
    const unsigned ldsw = (unsigned)wid * 1024u;
    const int aoff = lds_byte(wr * 64 + fr, fq * 8), boff = lds_byte(wc * 32 + fr, fq * 8);
    const int ldb = S.ldb;
    const size_t kstepW = (size_t)BK * (size_t)ldb;
    unsigned wgo = 0, wlo = 0;
    if (BF32) {
        static_assert(!BF32 || Epi::PERM, "the f32-weight staging assumes the permuted row slots");
        const int kq = 8 * (wid >> 2) + (lane >> 3), ng = 8 * (wid & 3) + (lane & 7);
        wgo = (unsigned)(4 * kq) * (unsigned)ldb + (unsigned)(16 * ng);
        const int c0 = 4 * ng;
        const int rho0 = Epi::PERM ? (16 * ((c0 >> 2) & 1) + 4 * ((c0 & 31) >> 3)) : (c0 & 31);
        wlo = (unsigned)lds_byte((c0 & ~31) + rho0, 4 * kq);
    }
    f32x4 wr0[4], wr1[4];
#define PG8_WISSUE(set, gbase) do { _Pragma("unroll") for (int _i = 0; _i < 4; ++_i) { const char* _p = (const char*)(gbase) + (size_t)_i * ldb; \
        asm volatile("global_load_dwordx4 %0, %1, %2" : "=v"(set[_i]) : "v"(wgo), "s"(_p) : "memory"); } } while (0)
#define PG8_WWAIT(set, n) asm volatile("s_waitcnt vmcnt(" #n ")" : "+v"(set[0]), "+v"(set[1]), "+v"(set[2]), "+v"(set[3]) :: "memory")
#define PG8_WCOMMIT(set, bufoff) do { _Pragma("unroll") for (int _j = 0; _j < 4; ++_j) { u32x2 _w; _w.x = cvt_pk_bf16(set[0][_j], set[1][_j]); _w.y = cvt_pk_bf16(set[2][_j], set[3][_j]); \
        *(LAS u32x2*)(lds + (bufoff) + wlo + 64 * _j) = _w; } } while (0)
#define PG8_SA(b, h) (((b) * 2 + (h)) * HTB)
#define PG8_SB(b, h) ((4 + (b) * 2 + (h)) * HTB)
#define PG8_STAGE2(bufoff, gbase, o0, o1) do { \
        __builtin_amdgcn_global_load_lds((const unsigned*)((const char*)(gbase) + (o0)), (LAS unsigned*)(lds + (bufoff) + ldsw), 16, 0, 0); \
        __builtin_amdgcn_global_load_lds((const unsigned*)((const char*)(gbase) + (o1)), (LAS unsigned*)(lds + (bufoff) + ldsw + 8192), 16, 0, 0); } while (0)
#define PG8_STAGEB(bufoff, gbase) PG8_STAGE2(bufoff, gbase, voffB[0], voffB[1])
#define PG8_STAGEA(bufoff, gbase, v, h) PG8_STAGE2(bufoff, gbase, (v)[(h) * 2], (v)[(h) * 2 + 1])
#define PG8_TREAD(par, h, e0, e1) do { int _tz = threadIdx.x; asm volatile("" : "+v"(_tz)); int _r0, _c0, _r1, _c1; stage_rc(_tz * 16, _r0, _c0); stage_rc(_tz * 16 + 8192, _r1, _c1); \
        const LAS int* _te = S.tbl_ent(par); e0 = _te[_r0 + 128 * (h)]; e1 = _te[_r1 + 128 * (h)]; } while (0)
#define PG8_STAGEA_G(bufoff, gbase, e0, e1) do { int _tz = threadIdx.x; asm volatile("" : "+v"(_tz)); int _r0, _c0, _r1, _c1; stage_rc(_tz * 16, _r0, _c0); stage_rc(_tz * 16 + 8192, _r1, _c1); \
        PG8_STAGE2(bufoff, gbase, (unsigned)((e0) >> 1) * (unsigned)S.lda + (unsigned)(_c0 * 2), (unsigned)((e1) >> 1) * (unsigned)S.lda + (unsigned)(_c1 * 2)); } while (0)
#define PG8_LDA(dst, b, h) do { _Pragma("unroll") for (int m = 0; m < 4; ++m) _Pragma("unroll") for (int k = 0; k < 2; ++k) dst[m][k] = *(const LAS bf16x8*)(lds + PG8_SA(b, h) + aoff + m * 2048 + k * 1024); } while (0)
#define PG8_LDB(dst, b, h) do { _Pragma("unroll") for (int n = 0; n < 2; ++n) _Pragma("unroll") for (int k = 0; k < 2; ++k) dst[n][k] = *(const LAS bf16x8*)(lds + PG8_SB(b, h) + boff + n * 2048 + k * 1024); } while (0)
#define PG8_MMA(ai, bj, At, Bt) do { __builtin_amdgcn_s_setprio(1); _Pragma("unroll") for (int m = 0; m < 4; ++m) _Pragma("unroll") for (int n = 0; n < 2; ++n) _Pragma("unroll") for (int k = 0; k < 2; ++k) \
        acc[ai][bj][m][n] = __builtin_amdgcn_mfma_f32_16x16x32_bf16(Bt[n][k], At[m][k], acc[ai][bj][m][n], 0, 0, 0); __builtin_amdgcn_s_setprio(0); } while (0)
#define PG8_WAIT_V(n) asm volatile("s_waitcnt vmcnt(" #n ")" ::: "memory")
#define PG8_WAIT_L(n) asm volatile("s_waitcnt lgkmcnt(" #n ")" ::: "memory")
#define PG8_BAR __builtin_amdgcn_s_barrier()
#define PG8_SCHED __builtin_amdgcn_sched_barrier(0)
    Unit cur, nxt; int ui = 0;
    if (!S.next(0, cur)) return;
    f32x4 acc[2][2][4][2];
#pragma unroll
    for (int a = 0; a < 2; ++a)
#pragma unroll
        for (int b = 0; b < 2; ++b)
#pragma unroll
            for (int m = 0; m < 4; ++m)
#pragma unroll
                for (int n = 0; n < 2; ++n) acc[a][b][m][n] = (f32x4){0.f, 0.f, 0.f, 0.f};
    bf16x8 At[4][2], B0[2][2], B1[2][2];
    constexpr bool GT = TBL && DYN;
    unsigned vc[4], vn[4];
    int ge0 = 0, ge1 = 0;
    int tb_e = 0, tb_v = 0;
    if constexpr (BF32) { PG8_WISSUE(wr0, cur.B); PG8_WISSUE(wr1, cur.B1); }
    if constexpr (TBL) {
        if (tid < 256) { const int e0 = *S.entry_ptr(cur, tid); S.tbl_ent(cur.par)[tid] = e0; S.tbl_val(cur.par)[tid] = *S.val_ptr(e0); }
        PG8_WAIT_L(0); PG8_BAR;
    }
    if constexpr (!GT) {
        S.aoffs(cur, Rr, Cc, vc);
#pragma unroll
        for (int j = 0; j < 4; ++j) vn[j] = vc[j];
    }
    const char* cA = cur.A; const char* cB = cur.B; const char* cB1 = cur.B1;
    if (!BF32) {
        PG8_STAGEB(PG8_SB(0, 0), cB); PG8_STAGEA(PG8_SA(0, 0), cA, vc, 0); PG8_STAGEB(PG8_SB(0, 1), cB + hstepB); PG8_STAGEA(PG8_SA(0, 1), cA, vc, 1);
        if (wr == 1) PG8_BAR;
        PG8_WAIT_V(4); PG8_BAR;
        PG8_STAGEB(PG8_SB(1, 0), cB + kstep); PG8_STAGEA(PG8_SA(1, 0), cA + kstep, vc, 0); PG8_STAGEB(PG8_SB(1, 1), cB + hstepB + kstep);
        PG8_WAIT_V(6); PG8_BAR;
    } else {
        if constexpr (GT) { PG8_TREAD(cur.par, 0, ge0, ge1); PG8_STAGEA_G(PG8_SA(0, 0), cA, ge0, ge1); PG8_TREAD(cur.par, 1, ge0, ge1); PG8_STAGEA_G(PG8_SA(0, 1), cA, ge0, ge1); }
        else { PG8_STAGEA(PG8_SA(0, 0), cA, vc, 0); PG8_STAGEA(PG8_SA(0, 1), cA, vc, 1); }
        PG8_WWAIT(wr0, 8); PG8_WCOMMIT(wr0, PG8_SB(0, 0)); PG8_WWAIT(wr1, 4); PG8_WCOMMIT(wr1, PG8_SB(0, 1));
        PG8_WISSUE(wr0, cB + kstepW); PG8_WISSUE(wr1, cB1 + kstepW);
        if constexpr (GT) { PG8_TREAD(cur.par, 0, ge0, ge1); PG8_STAGEA_G(PG8_SA(1, 0), cA + kstep, ge0, ge1); } else PG8_STAGEA(PG8_SA(1, 0), cA + kstep, vc, 0);
        PG8_WWAIT(wr0, 6); PG8_WCOMMIT(wr0, PG8_SB(1, 0));
        PG8_WISSUE(wr0, cB + 2 * kstepW);
        if constexpr (GT) PG8_TREAD(cur.par, 1, ge0, ge1);
        if (wr == 1) PG8_BAR;
        PG8_WAIT_V(4); PG8_WAIT_L(0); PG8_BAR;
        PG8_BAR;
    }
    for (;;) {
        const bool has_next = S.next(ui + 1, nxt);
        const bool full = !MSKIP || cur.cnt > 128;
        if constexpr (TBL) { if (has_next && tid < 256) { const int* ep = S.entry_ptr(nxt, tid); asm volatile("global_load_dword %0, %1, off" : "=v"(tb_e) : "v"(ep) : "memory"); } }
        const char* nA = has_next ? nxt.A : cA; const char* nB = has_next ? nxt.B : cB; const char* nB1 = has_next ? nxt.B1 : cB1;
        for (int t = 0; t < nt; t += 2) {
            const bool last = (t == nt - 2);
            const char* a1 = cA + (size_t)(t + 1) * kstep;
            const char* a2 = last ? nA : cA + (size_t)(t + 2) * kstep; const char* b2 = last ? nB : cB + (size_t)(t + 2) * kstep;
            const char* a3 = a2 + kstep; const char* b3 = b2 + kstep;
            const char* w21 = last ? nB1 : cB1 + (size_t)(t + 2) * kstepW;
            const char* w30 = last ? nB + kstepW : cB + (size_t)(t + 3) * kstepW;
            const char* w31 = last ? nB1 + kstepW : cB1 + (size_t)(t + 3) * kstepW;
            const char* w40 = last ? nB + 2 * kstepW : (t + 4 < nt ? cB + (size_t)(t + 4) * kstepW : nB);
            if constexpr (TBL) {
                if (has_next && tid < 256) {
                    if (t == (nt >> 1)) {
                        asm volatile("s_waitcnt vmcnt(10)" : "+v"(tb_e) :: "memory");
                        S.tbl_ent(nxt.par)[tid] = tb_e;
                        const float* vp = S.val_ptr(tb_e); asm volatile("global_load_dword %0, %1, off" : "=v"(tb_v) : "v"(vp) : "memory");
                    }
                    if (last) {
                        asm volatile("s_waitcnt vmcnt(10)" : "+v"(tb_v) :: "memory");
                        S.tbl_ent(nxt.par)[256 + tid] = tb_v;
                    }
                }
            }
            const int npar = (last && has_next) ? nxt.par : cur.par;
            if constexpr (GT) { PG8_STAGEA_G(PG8_SA(1, 1), a1, ge0, ge1); PG8_SCHED; }
            PG8_LDB(B0, 0, 0); PG8_SCHED; PG8_LDA(At, 0, 0);
            if constexpr (!GT) PG8_STAGEA(PG8_SA(1, 1), a1, vc, 1);
            PG8_WAIT_L(8); PG8_BAR; PG8_WAIT_L(0); PG8_MMA(0, 0, At, B0); PG8_BAR; PG8_SCHED;
            if (DYN && !GT) { if (last && has_next) {
                int tz = threadIdx.x; asm volatile("" : "+v"(tz)); int R2[2], C2[2];
#pragma unroll
                for (int i = 0; i < 2; ++i) stage_rc(tz * 16 + i * 8192, R2[i], C2[i]);
                S.aoffs(nxt, R2, C2, vn); } }
            PG8_LDB(B1, 0, 1);
            if (BF32) { PG8_WWAIT(wr1, 8); PG8_WCOMMIT(wr1, PG8_SB(1, 1)); PG8_WISSUE(wr1, w21); } else PG8_STAGEB(PG8_SB(0, 0), b2);
            if constexpr (GT) PG8_TREAD(npar, 0, ge0, ge1);
            PG8_BAR; PG8_WAIT_L(0); PG8_MMA(0, 1, At, B1); PG8_BAR;
            if constexpr (GT) { PG8_STAGEA_G(PG8_SA(0, 0), a2, ge0, ge1); PG8_SCHED; }
            if (full) PG8_LDA(At, 0, 1);
            if constexpr (!GT) PG8_STAGEA(PG8_SA(0, 0), a2, vn, 0);
            PG8_BAR; PG8_WAIT_L(0); if (full) PG8_MMA(1, 0, At, B0); PG8_BAR; PG8_SCHED;
            if (BF32) { PG8_WWAIT(wr0, 8); PG8_WCOMMIT(wr0, PG8_SB(0, 0)); PG8_WISSUE(wr0, w30); PG8_WAIT_V(10); } else { PG8_STAGEB(PG8_SB(0, 1), b2 + hstepB); PG8_WAIT_V(6); }
            if constexpr (GT) { PG8_TREAD(npar, 1, ge0, ge1); PG8_WAIT_L(0); }
            PG8_BAR; if (full) PG8_MMA(1, 1, At, B1); PG8_BAR;
            if constexpr (GT) { PG8_STAGEA_G(PG8_SA(0, 1), a2, ge0, ge1); PG8_SCHED; }
            PG8_LDB(B0, 1, 0); PG8_SCHED; PG8_LDA(At, 1, 0);
            if constexpr (!GT) PG8_STAGEA(PG8_SA(0, 1), a2, vn, 1);
            PG8_WAIT_L(8); PG8_BAR; PG8_WAIT_L(0); PG8_MMA(0, 0, At, B0); PG8_BAR; PG8_SCHED;
            PG8_LDB(B1, 1, 1);
            if (BF32) { PG8_WWAIT(wr1, 8); PG8_WCOMMIT(wr1, PG8_SB(0, 1)); PG8_WISSUE(wr1, w31); } else PG8_STAGEB(PG8_SB(1, 0), b3);
            if constexpr (GT) PG8_TREAD(npar, 0, ge0, ge1);
            PG8_BAR; PG8_WAIT_L(0); PG8_MMA(0, 1, At, B1); PG8_BAR;
            if constexpr (GT) { PG8_STAGEA_G(PG8_SA(1, 0), a3, ge0, ge1); PG8_SCHED; }
            if (full) PG8_LDA(At, 1, 1);
            if constexpr (!GT) PG8_STAGEA(PG8_SA(1, 0), a3, vn, 0);
            PG8_BAR; PG8_WAIT_L(0); if (full) PG8_MMA(1, 0, At, B0); PG8_BAR; PG8_SCHED;
            if (BF32) { PG8_WWAIT(wr0, 8); PG8_WCOMMIT(wr0, PG8_SB(1, 0)); PG8_WISSUE(wr0, w40); PG8_WAIT_V(10); } else { PG8_STAGEB(PG8_SB(1, 1), b3 + hstepB); PG8_WAIT_V(6); }
            if constexpr (GT) { PG8_TREAD(npar, 1, ge0, ge1); PG8_WAIT_L(0); }
            PG8_BAR; if (full) PG8_MMA(1, 1, At, B1); PG8_BAR;
        }
        if constexpr (PAIR) {
            if (cur.e == 0) E.first(acc, cur, wr, wc, fr, fq); else E(acc, cur, wr, wc, fr, fq);
        } else E(acc, cur, wr, wc, fr, fq);
        if (!has_next) break;
        if (!(PAIR && cur.e == 0)) {
#pragma unroll
        for (int a = 0; a < 2; ++a)
#pragma unroll
            for (int b = 0; b < 2; ++b)
#pragma unroll
                for (int m = 0; m < 4; ++m)
#pragma unroll
                    for (int n = 0; n < 2; ++n) acc[a][b][m][n] = (f32x4){0.f, 0.f, 0.f, 0.f};
        }
        cur = nxt; cA = nA; cB = nB; cB1 = nB1; ++ui;
        if (DYN && !GT) {
#pragma unroll
            for (int j = 0; j < 4; ++j) vc[j] = vn[j];
        }
    }
    PG8_WAIT_V(0);
    if (BF32) { asm volatile("" :: "v"(wr0[0]), "v"(wr0[1]), "v"(wr0[2]), "v"(wr0[3]), "v"(wr1[0]), "v"(wr1[1]), "v"(wr1[2]), "v"(wr1[3])); }
    if (wr == 0) PG8_BAR;
    PG8_BAR;
#undef PG8_WISSUE
#undef PG8_WCOMMIT
#undef PG8_WWAIT
#undef PG8_SA
#undef PG8_SB
#undef PG8_STAGE2
#undef PG8_STAGEA
#undef PG8_TREAD
#undef PG8_STAGEA_G
#undef PG8_STAGEB
#undef PG8_LDA
#undef PG8_LDB
#undef PG8_MMA
#undef PG8_WAIT_V
#undef PG8_WAIT_L
#undef PG8_BAR
#undef PG8_SCHED
}
}

constexpr int LDS_STAGE = pg8::STAGE_BYTES;
constexpr int LDS_WORK = 144 * 1024;
constexpr int MISC_OFF = LDS_WORK;
constexpr int LDS_BYTES = LDS_WORK + 12288;
constexpr int MOE_ROWTBL_OFF = MISC_OFF + 2048;

struct Args {
    const float* in[28];
    float* out; unsigned char* ws;
    int ph_lo, ph_hi;
};

struct Frame {
    LAS unsigned char* lds;
    const float* in[28]; float* out; unsigned char* ws;
    int tid, lane, wave, G, vb;
};

enum { I_X = 0, I_META, I_NORM_MIX, I_W_IN, I_SSD_CONV_W, I_SSD_CONV_B, I_SSD_DT_BIAS, I_SSD_A_LOG, I_SSD_D, I_SSD_NORM, I_W_SSD_OUT, I_LRU_CONV_W, I_LRU_CONV_B, I_LRU_WA, I_LRU_BA, I_LRU_WX, I_LRU_BX,
       I_LRU_LAMBDA, I_W_LRU_OUT, I_GATE_BIAS, I_W_OUT, I_NORM_FFN, I_W_RG, I_W_RE, I_W_EG, I_W_EU, I_W_ED, I_NORM_FINAL };

__device__ __forceinline__ int seq_row(int b, int t) { return t < NMETA ? T + t : b * SEQ + (t - NMETA); }

__device__ __forceinline__ int rowmap(int kind, int n) {
    switch (kind) {
        case 1: return n < 6144 ? n : (n < 6176 ? n + 8192 : n - 32);
        case 2: case 4: return (n >> 7) * 256 + (n & 127);
        case 3: case 5: return (n >> 7) * 256 + 128 + (n & 127);
        default: return n;
    }
}
__device__ void tconv(const Frame& F, const float* __restrict__ src, int K, int N, bf16_t* __restrict__ dst, int ldd, int kind, int& tilebase) {
    const int nbk = K / 64, nbn = N / 32, nblk = nbk * nbn;
    const int gw = F.vb * 8 + F.wave, nw = F.G * 8;
    int first = (gw - tilebase) % nw; if (first < 0) first += nw;
    const int ng = F.lane & 7, kg = F.lane >> 3;
    for (int t = first; t < nblk; t += nw) {
        const int bk = t % nbk, bn = t / nbk;
        const int n = bn * 32 + 4 * ng, k = bk * 64 + 8 * kg;
        f32x4 v[8];
#pragma unroll
        for (int i = 0; i < 8; ++i) v[i] = *(const f32x4*)(src + (size_t)(k + i) * N + n);
#pragma unroll
        for (int j = 0; j < 4; ++j) {
            u32x4 w; w.x = cvt_pk_bf16(v[0][j], v[1][j]); w.y = cvt_pk_bf16(v[2][j], v[3][j]); w.z = cvt_pk_bf16(v[4][j], v[5][j]); w.w = cvt_pk_bf16(v[6][j], v[7][j]);
            *(u32x4*)(dst + (size_t)rowmap(kind, n + j) * ldd + k) = w;
        }
    }
    tilebase += nblk;
}

__device__ void p0_prologue(const Frame& F) {
    {
        bf16_t* U = (bf16_t*)(F.ws + WS_U);
        const float* g = F.in[I_NORM_MIX];
        for (int row = F.vb * 8 + F.wave; row < TR; row += F.G * 8) {
            const float* src = row < T ? F.in[I_X] + (size_t)row * D : F.in[I_META] + (size_t)(row - T) * D;
            f32x4 v[8]; float ss = 0.f;
#pragma unroll
            for (int i = 0; i < 8; ++i) { v[i] = *(const f32x4*)(src + i * 256 + F.lane * 4); ss += v[i][0] * v[i][0] + v[i][1] * v[i][1] + v[i][2] * v[i][2] + v[i][3] * v[i][3]; }
            ss = wave_sum(ss);
            const float rstd = rsqrtf(ss * (1.0f / D) + EPS);
#pragma unroll
            for (int i = 0; i < 8; ++i) {
                const f32x4 gg = *(const f32x4*)(g + i * 256 + F.lane * 4);
                u32x2 w; w.x = cvt_pk_bf16(v[i][0] * rstd * gg[0], v[i][1] * rstd * gg[1]); w.y = cvt_pk_bf16(v[i][2] * rstd * gg[2], v[i][3] * rstd * gg[3]);
                *(u32x2*)(U + (size_t)row * D + i * 256 + F.lane * 4) = w;
            }
        }
    }
    {
        bf16_t* WH = (bf16_t*)(F.ws + WS_WRH); bf16_t* WL = (bf16_t*)(F.ws + WS_WRL);
        const float* wrg = F.in[I_W_RG]; const float* wre = F.in[I_W_RE];
        for (int i = F.vb * NTHREADS + F.tid; i < 96 * 2048; i += F.G * NTHREADS) {
            const int n = i >> 11, k = i & 2047;
            const float v = n < 8 ? wrg[(size_t)k * 8 + n] : (n < 72 ? wre[(size_t)k * 64 + (n - 8)] : 0.f);
            const unsigned short hi = f2bf(v);
            WH[i] = hi; WL[i] = f2bf(v - bf2f(hi));
        }
    }
    int tb = 0;
    tconv(F, F.in[I_W_IN], 2048, 14368, (bf16_t*)(F.ws + WS_WIN), 2048, 1, tb);
    tconv(F, F.in[I_W_SSD_OUT], 2048, 2048, (bf16_t*)(F.ws + WS_WSO), 2048, 0, tb);
    tconv(F, F.in[I_W_LRU_OUT], 2048, 2048, (bf16_t*)(F.ws + WS_WLO), 2048, 0, tb);
    tconv(F, F.in[I_W_OUT], 2048, 2048, (bf16_t*)(F.ws + WS_WOUT), 2048, 0, tb);
    for (int h = 0; h < 8; ++h) {
        tconv(F, F.in[I_LRU_WA] + (size_t)h * 65536, 256, 256, (bf16_t*)(F.ws + WS_WLRU) + (size_t)h * 512 * 256, 256, 4, tb);
        tconv(F, F.in[I_LRU_WX] + (size_t)h * 65536, 256, 256, (bf16_t*)(F.ws + WS_WLRU) + (size_t)h * 512 * 256, 256, 5, tb);
    }
}

struct EpiProj {
    static constexpr bool PERM = true;
    bf16_t* P; const float* gate_bias;
    __device__ __forceinline__ void operator()(const f32x4 (&acc)[2][2][4][2], const pg8::Unit& u, int wr, int wc, int fr, int fq) const {
        const int row0 = u.pm * 256 + wr * 64 + fr, col0 = u.pn * 256 + wc * 32 + 8 * fq;
        const int kind = u.pn < 8 ? 0 : (u.pn < 32 ? 1 : (u.pn < 40 ? 2 : 3));
#pragma unroll
        for (int bj = 0; bj < 2; ++bj) {
            f32x4 b0 = (f32x4){0.f, 0.f, 0.f, 0.f}, b1 = b0;
            if (kind == 3) { b0 = *(const f32x4*)(gate_bias + (col0 + bj * 128 - OGL)); b1 = *(const f32x4*)(gate_bias + (col0 + bj * 128 - OGL) + 4); }
#pragma unroll
            for (int ai = 0; ai < 2; ++ai)
#pragma unroll
                for (int m = 0; m < 4; ++m) {
                    f32x4 v0 = acc[ai][bj][m][0], v1 = acc[ai][bj][m][1];
                    if (kind == 0) {
#pragma unroll
                        for (int j = 0; j < 4; ++j) { v0[j] = siluf_(v0[j]); v1[j] = siluf_(v1[j]); }
                    } else if (kind == 2) {
#pragma unroll
                        for (int j = 0; j < 4; ++j) { v0[j] = gelu_tanh_(v0[j]); v1[j] = gelu_tanh_(v1[j]); }
                    } else if (kind == 3) {
#pragma unroll
                        for (int j = 0; j < 4; ++j) { v0[j] = sigmoidf_(v0[j] + b0[j]); v1[j] = sigmoidf_(v1[j] + b1[j]); }
                    }
                    u32x4 w; w.x = cvt_pk_bf16(v0[0], v0[1]); w.y = cvt_pk_bf16(v0[2], v0[3]); w.z = cvt_pk_bf16(v1[0], v1[1]); w.w = cvt_pk_bf16(v1[2], v1[3]);
                    *(u32x4*)(P + (size_t)(row0 + ai * 128 + m * 16) * NP + col0 + bj * 128) = w;
                }
        }
    }
};

struct EpiLru {
    static constexpr bool PERM = true;
    const bf16_t* XR; bf16_t* LOGA; bf16_t* LU; const float* ba; const float* bx; const float* lam;
    __device__ __forceinline__ void operator()(const f32x4 (&acc)[2][2][4][2], const pg8::Unit& u, int wr, int wc, int fr, int fq) const {
        const int row0 = u.pm * 256 + wr * 64 + fr;
#pragma unroll
        for (int n = 0; n < 2; ++n) {
            const int ch0 = (u.pn >> 1) * 256 + (u.pn & 1) * 128 + wc * 32 + 8 * fq + 4 * n;
            const f32x4 bav = *(const f32x4*)(ba + ch0), bxv = *(const f32x4*)(bx + ch0), lmv = *(const f32x4*)(lam + ch0);
            f32x4 spl;
#pragma unroll
            for (int j = 0; j < 4; ++j) spl[j] = -8.0f * softplusf_(-lmv[j]);
            u32x2 xq[8];
#pragma unroll
            for (int q = 0; q < 8; ++q) { const bf16_t* xp = XR + (size_t)(row0 + (q >> 2) * 128 + (q & 3) * 16) * D + ch0; asm volatile("global_load_dwordx2 %0, %1, off" : "=v"(xq[q]) : "v"(xp) : "memory"); }
            asm volatile("s_waitcnt vmcnt(0)" : "+v"(xq[0]), "+v"(xq[1]), "+v"(xq[2]), "+v"(xq[3]), "+v"(xq[4]), "+v"(xq[5]), "+v"(xq[6]), "+v"(xq[7]) :: "memory");
#pragma unroll
            for (int ai = 0; ai < 2; ++ai)
#pragma unroll
                for (int m = 0; m < 4; ++m) {
                    const size_t off = (size_t)(row0 + ai * 128 + m * 16) * D + ch0;
                    const u32x2 xw = xq[ai * 4 + m];
                    const float xr[4] = {bflo(xw.x), bfhi(xw.x), bflo(xw.y), bfhi(xw.y)};
                    float la[4], uu[4];
#pragma unroll
                    for (int j = 0; j < 4; ++j) {
                        const float pr = acc[ai][0][m][n][j] + bav[j], pi = acc[ai][1][m][n][j] + bxv[j];
                        const float l = spl[j] * sigmoidf_(pr);
                        la[j] = l;
                        uu[j] = __builtin_amdgcn_sqrtf(fmaxf(1.0f - __expf(2.0f * l), 0.0f)) * sigmoidf_(pi) * xr[j];
                    }
                    u32x2 w; w.x = cvt_pk_bf16(la[0], la[1]); w.y = cvt_pk_bf16(la[2], la[3]);
                    *(u32x2*)(LOGA + off) = w;
                    w.x = cvt_pk_bf16(uu[0], uu[1]); w.y = cvt_pk_bf16(uu[2], uu[3]);
                    *(u32x2*)(LU + off) = w;
                }
        }
    }
};

struct EpiMixPair {
    static constexpr bool PERM = true;
    const bf16_t* P; bf16_t* MIX;
    __device__ __forceinline__ void first(f32x4 (&acc)[2][2][4][2], const pg8::Unit& u, int wr, int wc, int fr, int fq) const {
        const int row0 = u.pm * 256 + wr * 64 + fr, col0 = u.pn * 256 + wc * 32 + 8 * fq;
#pragma unroll
        for (int ai = 0; ai < 2; ++ai) {
            u32x4 ga[8], gb[8];
#pragma unroll
            for (int m = 0; m < 4; ++m) {
                const bf16_t* gp = P + (size_t)(row0 + ai * 128 + m * 16) * NP + OGL + col0;
                asm volatile("global_load_dwordx4 %0, %1, off" : "=v"(ga[m * 2 + 0]) : "v"(gp) : "memory");
                asm volatile("global_load_dwordx4 %0, %1, off offset:256" : "=v"(ga[m * 2 + 1]) : "v"(gp) : "memory");
                asm volatile("global_load_dwordx4 %0, %1, off" : "=v"(gb[m * 2 + 0]) : "v"(gp + D) : "memory");
                asm volatile("global_load_dwordx4 %0, %1, off offset:256" : "=v"(gb[m * 2 + 1]) : "v"(gp + D) : "memory");
            }
            asm volatile("s_waitcnt vmcnt(0)" : "+v"(ga[0]), "+v"(ga[1]), "+v"(ga[2]), "+v"(ga[3]), "+v"(ga[4]), "+v"(ga[5]), "+v"(ga[6]), "+v"(ga[7]),
                         "+v"(gb[0]), "+v"(gb[1]), "+v"(gb[2]), "+v"(gb[3]), "+v"(gb[4]), "+v"(gb[5]), "+v"(gb[6]), "+v"(gb[7]) :: "memory");
#pragma unroll
            for (int m = 0; m < 4; ++m)
#pragma unroll
                for (int bj = 0; bj < 2; ++bj) {
                    const u32x4 a = ga[m * 2 + bj], b = gb[m * 2 + bj];
                    const float r[8] = {bflo(a.x) * __builtin_amdgcn_rcpf(bflo(b.x)), bfhi(a.x) * __builtin_amdgcn_rcpf(bfhi(b.x)), bflo(a.y) * __builtin_amdgcn_rcpf(bflo(b.y)), bfhi(a.y) * __builtin_amdgcn_rcpf(bfhi(b.y)),
                                        bflo(a.z) * __builtin_amdgcn_rcpf(bflo(b.z)), bfhi(a.z) * __builtin_amdgcn_rcpf(bfhi(b.z)), bflo(a.w) * __builtin_amdgcn_rcpf(bflo(b.w)), bfhi(a.w) * __builtin_amdgcn_rcpf(bfhi(b.w))};
#pragma unroll
                    for (int j = 0; j < 4; ++j) { acc[ai][bj][m][0][j] *= r[j]; acc[ai][bj][m][1][j] *= r[4 + j]; }
                }
        }
    }
    __device__ __forceinline__ void operator()(const f32x4 (&acc)[2][2][4][2], const pg8::Unit& u, int wr, int wc, int fr, int fq) const {
        const int row0 = u.pm * 256 + wr * 64 + fr, col0 = u.pn * 256 + wc * 32 + 8 * fq;
#pragma unroll
        for (int ai = 0; ai < 2; ++ai) {
            u32x4 gg[8];
#pragma unroll
            for (int m = 0; m < 4; ++m) {
                const bf16_t* gp = P + (size_t)(row0 + ai * 128 + m * 16) * NP + OGL + D + col0;
                asm volatile("global_load_dwordx4 %0, %1, off" : "=v"(gg[m * 2 + 0]) : "v"(gp) : "memory");
                asm volatile("global_load_dwordx4 %0, %1, off offset:256" : "=v"(gg[m * 2 + 1]) : "v"(gp) : "memory");
            }
            asm volatile("s_waitcnt vmcnt(0)" : "+v"(gg[0]), "+v"(gg[1]), "+v"(gg[2]), "+v"(gg[3]), "+v"(gg[4]), "+v"(gg[5]), "+v"(gg[6]), "+v"(gg[7]) :: "memory");
#pragma unroll
            for (int m = 0; m < 4; ++m)
#pragma unroll
                for (int bj = 0; bj < 2; ++bj) {
                    const int row = row0 + ai * 128 + m * 16, col = col0 + bj * 128;
                    const u32x4 gw = gg[m * 2 + bj];
                    const float g[8] = {bflo(gw.x), bfhi(gw.x), bflo(gw.y), bfhi(gw.y), bflo(gw.z), bfhi(gw.z), bflo(gw.w), bfhi(gw.w)};
                    f32x4 v0 = acc[ai][bj][m][0], v1 = acc[ai][bj][m][1];
#pragma unroll
                    for (int j = 0; j < 4; ++j) { v0[j] *= g[j]; v1[j] *= g[4 + j]; }
                    u32x4 w; w.x = cvt_pk_bf16(v0[0], v0[1]); w.y = cvt_pk_bf16(v0[2], v0[3]); w.z = cvt_pk_bf16(v1[0], v1[1]); w.w = cvt_pk_bf16(v1[2], v1[3]);
                    *(u32x4*)(MIX + (size_t)row * D + col) = w;
                }
        }
    }
};

struct EpiRes {
    static constexpr bool PERM = false;
    const float* X; float* H1;
    __device__ __forceinline__ void operator()(const f32x4 (&acc)[2][2][4][2], const pg8::Unit& u, int wr, int wc, int fr, int fq) const {
        const int row0 = u.pm * 256 + wr * 64 + fr, col0 = u.pn * 256 + wc * 32 + 4 * fq;
#pragma unroll
        for (int ai = 0; ai < 2; ++ai) {
            f32x4 x[16];
#pragma unroll
            for (int m = 0; m < 4; ++m) {
                const float* xp = X + (size_t)(row0 + ai * 128 + m * 16) * D + col0;
                asm volatile("global_load_dwordx4 %0, %1, off" : "=v"(x[m * 4 + 0]) : "v"(xp) : "memory");
                asm volatile("global_load_dwordx4 %0, %1, off offset:64" : "=v"(x[m * 4 + 1]) : "v"(xp) : "memory");
                asm volatile("global_load_dwordx4 %0, %1, off offset:512" : "=v"(x[m * 4 + 2]) : "v"(xp) : "memory");
                asm volatile("global_load_dwordx4 %0, %1, off offset:576" : "=v"(x[m * 4 + 3]) : "v"(xp) : "memory");
            }
            asm volatile("s_waitcnt vmcnt(0)" : "+v"(x[0]), "+v"(x[1]), "+v"(x[2]), "+v"(x[3]), "+v"(x[4]), "+v"(x[5]), "+v"(x[6]), "+v"(x[7]),
                         "+v"(x[8]), "+v"(x[9]), "+v"(x[10]), "+v"(x[11]), "+v"(x[12]), "+v"(x[13]), "+v"(x[14]), "+v"(x[15]) :: "memory");
#pragma unroll
            for (int m = 0; m < 4; ++m)
#pragma unroll
                for (int bj = 0; bj < 2; ++bj)
#pragma unroll
                    for (int n = 0; n < 2; ++n) {
                        const size_t off = (size_t)(row0 + ai * 128 + m * 16) * D + col0 + bj * 128 + n * 16;
                        *(f32x4*)(H1 + off) = x[m * 4 + bj * 2 + n] + acc[ai][bj][m][n];
                    }
        }
    }
};

struct EpiMoe1 {
    static constexpr bool PERM = true;
    bf16_t* H; LAS const unsigned char* rowtbl;
    __device__ __forceinline__ void operator()(const f32x4 (&acc)[2][2][4][2], const pg8::Unit& u, int wr, int wc, int fr, int fq) const {
        const int lrow0 = wr * 64 + fr, row0 = u.pm * 256 + lrow0, col0 = u.pn * 128 + wc * 32 + 8 * fq;
        const LAS float* tv = (const LAS float*)(rowtbl + u.par * 2048 + 1024);
#pragma unroll
        for (int ai = 0; ai < 2; ++ai)
#pragma unroll
            for (int m = 0; m < 4; ++m) {
                const float rs = tv[lrow0 + ai * 128 + m * 16];
                float h[8];
#pragma unroll
                for (int j = 0; j < 8; ++j) h[j] = siluf_(rs * acc[ai][0][m][j >> 2][j & 3]) * (rs * acc[ai][1][m][j >> 2][j & 3]);
                u32x4 w; w.x = cvt_pk_bf16(h[0], h[1]); w.y = cvt_pk_bf16(h[2], h[3]); w.z = cvt_pk_bf16(h[4], h[5]); w.w = cvt_pk_bf16(h[6], h[7]);
                *(u32x4*)(H + (size_t)(row0 + ai * 128 + m * 16) * FF + col0) = w;
            }
    }
};

struct EpiMoe2 {
    static constexpr bool PERM = true;
    bf16_t* Y; LAS const unsigned char* rowtbl;
    __device__ __forceinline__ void operator()(const f32x4 (&acc)[2][2][4][2], const pg8::Unit& u, int wr, int wc, int fr, int fq) const {
        const int lrow0 = wr * 64 + fr, col0 = u.pn * 256 + wc * 32 + 8 * fq;
        const LAS int* te = (const LAS int*)(rowtbl + u.par * 2048);
        const LAS float* tv = (const LAS float*)(rowtbl + u.par * 2048 + 1024);
#pragma unroll
        for (int ai = 0; ai < 2; ++ai)
#pragma unroll
            for (int m = 0; m < 4; ++m) {
                const int lr = lrow0 + ai * 128 + m * 16;
                if (lr < u.cnt) {
                    const int ent = te[lr]; const float g = tv[lr];
#pragma unroll
                    for (int bj = 0; bj < 2; ++bj) {
                        const f32x4 v0 = acc[ai][bj][m][0] * g, v1 = acc[ai][bj][m][1] * g;
                        u32x4 w; w.x = cvt_pk_bf16(v0[0], v0[1]); w.y = cvt_pk_bf16(v0[2], v0[3]); w.z = cvt_pk_bf16(v1[0], v1[1]); w.w = cvt_pk_bf16(v1[2], v1[3]);
                        *(u32x4*)(Y + (size_t)ent * D + col0 + bj * 128) = w;
                    }
                }
            }
    }
};

__device__ void p1_thin(const Frame& F) {
    const bf16_t* U = (const bf16_t*)(F.ws + WS_U);
    const bf16_t* W = (const bf16_t*)(F.ws + WS_WIN);
    bf16_t* P = (bf16_t*)(F.ws + WS_PROJ);
    float* DT = (float*)(F.ws + WS_DT);
    const int NDT = 513, NMT = 192, NIT = NDT + NMT;
    LAS float* red = (LAS float*)F.lds;
    const int r = F.lane & 31, h = F.lane >> 5, quad = F.wave >> 2, kq = F.wave & 3;
    for (int base = F.vb * 2; base < NIT; base += F.G * 2) {
        const int it = base + quad;
        const bool act = it < NIT;
        int row0 = 0, bcol0 = NP, nvalid = 0;
        if (act) {
            if (it < NDT) { row0 = it * 32; bcol0 = NP; nvalid = (TR - row0) < 32 ? (TR - row0) : 32; }
            else { row0 = T; bcol0 = OXBC + (it - NDT) * 32; nvalid = 16; }
        }
        f32x16 acc;
#pragma unroll
        for (int j = 0; j < 16; ++j) acc[j] = 0.f;
        if (act) {
            const int arow = row0 + (r < nvalid ? r : 0);
            const bf16_t* ap = U + (size_t)arow * D + kq * 512 + 8 * h;
            const bf16_t* bp = W + (size_t)(bcol0 + r) * D + kq * 512 + 8 * h;
#pragma unroll 1
            for (int kb = 0; kb < 512; kb += 128) {
                bf16x8 fa[8], fb[8];
#pragma unroll
                for (int k = 0; k < 8; ++k) { fa[k] = *(const bf16x8*)(ap + kb + k * 16); fb[k] = *(const bf16x8*)(bp + kb + k * 16); }
                __builtin_amdgcn_sched_barrier(0);
#pragma unroll
                for (int k = 0; k < 8; ++k) acc = __builtin_amdgcn_mfma_f32_32x32x16_bf16(fa[k], fb[k], acc, 0, 0, 0);
            }
        }
#pragma unroll
        for (int j = 0; j < 16; ++j) red[((quad * 4 + kq) * 16 + j) * 64 + F.lane] = acc[j];
        __syncthreads();
        if (act && kq == 0) {
#pragma unroll
            for (int j = 0; j < 16; ++j) {
                const float v = (red[((quad * 4 + 0) * 16 + j) * 64 + F.lane] + red[((quad * 4 + 1) * 16 + j) * 64 + F.lane]) + (red[((quad * 4 + 2) * 16 + j) * 64 + F.lane] + red[((quad * 4 + 3) * 16 + j) * 64 + F.lane]);
                const int i = (j & 3) + 8 * (j >> 2) + 4 * h;
                if (i < nvalid) {
                    if (it < NDT) DT[(size_t)(row0 + i) * 32 + r] = v;
                    else P[(size_t)(row0 + i) * NP + bcol0 + r] = f2bf(v);
                }
            }
        }
        __syncthreads();
    }
}

__device__ void p2_conv(const Frame& F) {
    const bf16_t* P = (const bf16_t*)(F.ws + WS_PROJ);
    bf16_t* XR = (bf16_t*)(F.ws + WS_XR);
    bf16_t* XS = (bf16_t*)(F.ws + WS_XBCS);
    const int cgl = F.tid & 255, rsel = F.tid >> 8;
    constexpr int NU_X = 3 * NBATCH * 128, NU = NU_X + 3;
    for (int u = F.vb; u < NU; u += F.G) {
        int cbk, b, t0;
        if (u < NU_X) { cbk = u % 3; const int q = u / 3; b = q >> 7; t0 = NMETA + ((q & 127) * 2 + rsel) * 8; }
        else { cbk = u - NU_X; b = 0; t0 = rsel * 8; }
        const int cgx = cbk * 256 + cgl;
        const bool isx = cgx < 512;
        const int c0 = isx ? cgx * 8 : (cgx - 512) * 8;
        const float* cw = isx ? F.in[I_SSD_CONV_W] : F.in[I_LRU_CONV_W];
        const float* cb = isx ? F.in[I_SSD_CONV_B] : F.in[I_LRU_CONV_B];
        const int cwld = isx ? 4096 : D;
        const int pcol = (isx ? OXBC : OLX) + c0;
        u32x4 raw[11];
        if (u < NU_X) {
#pragma unroll
            for (int m = 0; m < 11; ++m) raw[m] = *(const u32x4*)(P + (size_t)seq_row(b, t0 - 3 + m) * NP + pcol);
        } else {
#pragma unroll
            for (int m = 0; m < 11; ++m) { const int t = t0 - 3 + m; const u32x4 v = *(const u32x4*)(P + (size_t)seq_row(b, t < 0 ? 0 : t) * NP + pcol); raw[m] = t >= 0 ? v : (u32x4){0u, 0u, 0u, 0u}; }
        }
        u32x2 outw[8][2];
#pragma unroll
        for (int hh = 0; hh < 2; ++hh) {
            const f32x4 b0 = *(const f32x4*)(cb + c0 + 4 * hh);
            f32x4 wg[4];
#pragma unroll
            for (int k = 0; k < 4; ++k) wg[k] = *(const f32x4*)(cw + k * cwld + c0 + 4 * hh);
            f32x4 o[8];
#pragma unroll
            for (int i = 0; i < 8; ++i) o[i] = b0;
#pragma unroll
            for (int m = 0; m < 11; ++m) {
                const unsigned d0 = hh ? raw[m].z : raw[m].x, d1 = hh ? raw[m].w : raw[m].y;
                const f32x4 x = (f32x4){bflo(d0), bfhi(d0), bflo(d1), bfhi(d1)};
#pragma unroll
                for (int k = 0; k < 4; ++k) { const int i = m - k; if (i >= 0 && i < 8) o[i] += wg[k] * x; }
            }
#pragma unroll
            for (int i = 0; i < 8; ++i) {
                f32x4 v = o[i];
                if (isx) { v[0] = siluf_(v[0]); v[1] = siluf_(v[1]); v[2] = siluf_(v[2]); v[3] = siluf_(v[3]); }
                outw[i][hh].x = cvt_pk_bf16(v[0], v[1]); outw[i][hh].y = cvt_pk_bf16(v[2], v[3]);
            }
        }
#pragma unroll
        for (int i = 0; i < 8; ++i) {
            const size_t row = (size_t)seq_row(b, t0 + i);
            u32x4 w; w.x = outw[i][0].x; w.y = outw[i][0].y; w.z = outw[i][1].x; w.w = outw[i][1].y;
            if (isx) *(u32x4*)(XS + row * 4096 + c0) = w; else *(u32x4*)(XR + row * D + c0) = w;
        }
    }
}

__device__ __forceinline__ float ssd_dtload(const float* DT, int b, int head, int ci, int lane) {
    const int t = ci * 64 - 48 + lane;
    return t >= 0 ? DT[(size_t)seq_row(b, t) * 32 + head] : 0.f;
}
__device__ __forceinline__ void ssd_scal(float dtraw, int ci, float dtb, float a_neg, LAS float* scb, int lane) {
    const int t = ci * 64 - 48 + lane;
    float dtv = 0.f;
    if (t >= 0) dtv = softplusf_(dtraw + dtb);
    float cs = dtv * a_neg;
#pragma unroll
    for (int o = 1; o < 64; o <<= 1) { const float v = __shfl_up(cs, o); if (lane >= o) cs += v; }
    const float tot = __shfl(cs, 63);
    scb[lane] = cs; scb[64 + lane] = dtv; scb[128 + lane] = dtv * __expf(tot - cs);
}
__device__ __forceinline__ void ssd_writeout(const LAS unsigned char* yb, const u32x4 zw, bf16_t* dst) {
    const f32x4 y0 = *(const LAS f32x4*)yb, y1 = *(const LAS f32x4*)(yb + 16);
    u32x4 w; w.x = cvt_pk_bf16(y0[0] * bflo(zw.x), y0[1] * bfhi(zw.x)); w.y = cvt_pk_bf16(y0[2] * bflo(zw.y), y0[3] * bfhi(zw.y));
    w.z = cvt_pk_bf16(y1[0] * bflo(zw.z), y1[1] * bfhi(zw.z)); w.w = cvt_pk_bf16(y1[2] * bflo(zw.w), y1[3] * bfhi(zw.w));
    *(u32x4*)dst = w;
}
constexpr int W2_BLOCKS = NEXP * (D / 32) * (FF / 64);
__device__ __forceinline__ void w2_issue(const float* __restrict__ w2, int blk, int lane, f32x4 (&v)[8]) {
    const int e = blk >> 10, bn = (blk >> 4) & 63, bk = blk & 15, ng = lane & 7, kg = lane >> 3;
    const float* src = w2 + (size_t)e * FF * D + (size_t)(bk * 64 + 8 * kg) * D + bn * 32 + 4 * ng;
#pragma unroll
    for (int i = 0; i < 8; ++i) v[i] = *(const f32x4*)(src + (size_t)i * D);
}
__device__ __forceinline__ void w2_commit(bf16_t* __restrict__ w2t, int blk, int lane, const f32x4 (&v)[8]) {
    const int e = blk >> 10, bn = (blk >> 4) & 63, bk = blk & 15, ng = lane & 7, kg = lane >> 3;
    bf16_t* dst = w2t + (size_t)e * D * FF + (size_t)(bn * 32 + 4 * ng) * FF + bk * 64 + 8 * kg;
#pragma unroll
    for (int j = 0; j < 4; ++j) {
        u32x4 w; w.x = cvt_pk_bf16(v[0][j], v[1][j]); w.y = cvt_pk_bf16(v[2][j], v[3][j]); w.z = cvt_pk_bf16(v[4][j], v[5][j]); w.w = cvt_pk_bf16(v[6][j], v[7][j]);
        *(u32x4*)(dst + (size_t)j * FF) = w;
    }
}
__device__ void p2_ssd_chunk(const Frame& F) {
    const bf16_t* P = (const bf16_t*)(F.ws + WS_PROJ);
    const float* DT = (const float*)(F.ws + WS_DT);
    bf16_t* Y = (bf16_t*)(F.ws + WS_YSSD);
    const bf16_t* XS = (const bf16_t*)(F.ws + WS_XBCS);
    LAS unsigned char* L = F.lds;
    constexpr int RSN = 272, RSS = 144;
    constexpr int O_CM = 0, O_BM = O_CM + 64 * RSN, O_BMT = O_BM + 64 * RSN, O_XST = O_BMT + 128 * RSS, O_XWT = O_XST + 64 * RSS, O_MM = O_XWT + 64 * RSS,
                  O_ST0 = O_MM + 64 * RSS, O_ST1 = O_ST0 + 64 * RSN, O_SC = O_ST1 + 64 * RSN, O_YB = O_SC + 2 * 192 * 4;
    static_assert(O_YB + 64 * RSN <= LDS_WORK, "ssd lds");
    LAS float* sc = (LAS float*)(L + O_SC);
    const int tid = F.tid, lane = F.lane, wave = F.wave, r = lane & 31, h = lane >> 5;
    const bool cv = tid < 320;
    const int cg = tid >> 3, run = tid & 7, i0 = run * 8;
    const float* W2 = F.in[I_W_ED]; bf16_t* W2T = (bf16_t*)(F.ws + WS_W2);
    f32x4 cb0[8];
    int cstep = 0;
    for (int unit = F.vb; unit < NBATCH * NHEAD; unit += F.G) {
        const int b = unit >> 5, head = unit & 31, grp = head >> 2;
        const float a_neg = -__expf(F.in[I_SSD_A_LOG][head]), dtb = F.in[I_SSD_DT_BIAS][head], dsk = F.in[I_SSD_D][head];
        const int cc = cg < 8 ? head * 64 + cg * 8 : (cg < 24 ? 2048 + grp * 128 + (cg - 8) * 8 : 3072 + grp * 128 + (cg - 24) * 8);
        f32x16 st0, st1;
#pragma unroll
        for (int j = 0; j < 16; ++j) { st0[j] = 0.f; st1[j] = 0.f; }
        for (int i = tid; i < 64 * RSN / 16; i += NTHREADS) *(LAS u32x4*)(L + O_ST0 + i * 16) = (u32x4){0u, 0u, 0u, 0u};
        u32x4 raw[8];
        if (cv) {
#pragma unroll
            for (int i = 0; i < 8; ++i) { const int t = -48 + i0 + i; raw[i] = (u32x4){0u, 0u, 0u, 0u}; if (t >= 0) raw[i] = *(const u32x4*)(XS + (size_t)seq_row(b, t) * 4096 + cc); }
        }
        float dtn = 0.f;
        if (wave == 7) { ssd_scal(ssd_dtload(DT, b, head, 0, lane), 0, dtb, a_neg, sc, lane); dtn = ssd_dtload(DT, b, head, 1, lane); }
        u32x4 zw = (u32x4){0u, 0u, 0u, 0u};
        __syncthreads();
        for (int ci = 0; ci < 33; ++ci) {
            LAS float* scc = sc + (ci & 1) * 192;
            const int stc = (ci & 1) ? O_ST1 : O_ST0, stn = (ci & 1) ? O_ST0 : O_ST1;
            const int wl = tid >> 3, wc8 = (tid & 7) * 8;
            if (cv) {
                if (cg >= 8) {
                    const int n0 = cg < 24 ? (cg - 8) * 8 : (cg - 24) * 8;
                    const int ob = cg < 24 ? O_BM : O_CM;
#pragma unroll
                    for (int i = 0; i < 8; ++i) *(LAS u32x4*)(L + ob + (i0 + i) * RSN + n0 * 2) = raw[i];
                }
                if (cg < 24) {
                    const int n0 = cg < 8 ? cg * 8 : (cg - 8) * 8;
                    const int ob = cg < 8 ? O_XST : O_BMT;
#pragma unroll
                    for (int d = 0; d < 4; ++d) {
                        u32x4 lo, hi;
                        lo.x = (raw[0][d] & 0xffffu) | (raw[1][d] << 16); lo.y = (raw[2][d] & 0xffffu) | (raw[3][d] << 16); lo.z = (raw[4][d] & 0xffffu) | (raw[5][d] << 16); lo.w = (raw[6][d] & 0xffffu) | (raw[7][d] << 16);
                        hi.x = (raw[0][d] >> 16) | (raw[1][d] & 0xffff0000u); hi.y = (raw[2][d] >> 16) | (raw[3][d] & 0xffff0000u); hi.z = (raw[4][d] >> 16) | (raw[5][d] & 0xffff0000u); hi.w = (raw[6][d] >> 16) | (raw[7][d] & 0xffff0000u);
                        *(LAS u32x4*)(L + ob + (n0 + 2 * d) * RSS + i0 * 2) = lo;
                        *(LAS u32x4*)(L + ob + (n0 + 2 * d + 1) * RSS + i0 * 2) = hi;
                    }
                    if (cg < 8) {
                        const f32x4 w0 = *(const LAS f32x4*)(scc + 128 + i0), w1 = *(const LAS f32x4*)(scc + 128 + i0 + 4);
#pragma unroll
                        for (int d = 0; d < 4; ++d) {
                            u32x4 lo, hi;
                            lo.x = cvt_pk_bf16(bflo(raw[0][d]) * w0[0], bflo(raw[1][d]) * w0[1]); lo.y = cvt_pk_bf16(bflo(raw[2][d]) * w0[2], bflo(raw[3][d]) * w0[3]);
                            lo.z = cvt_pk_bf16(bflo(raw[4][d]) * w1[0], bflo(raw[5][d]) * w1[1]); lo.w = cvt_pk_bf16(bflo(raw[6][d]) * w1[2], bflo(raw[7][d]) * w1[3]);
                            hi.x = cvt_pk_bf16(bfhi(raw[0][d]) * w0[0], bfhi(raw[1][d]) * w0[1]); hi.y = cvt_pk_bf16(bfhi(raw[2][d]) * w0[2], bfhi(raw[3][d]) * w0[3]);
                            hi.z = cvt_pk_bf16(bfhi(raw[4][d]) * w1[0], bfhi(raw[5][d]) * w1[1]); hi.w = cvt_pk_bf16(bfhi(raw[6][d]) * w1[2], bfhi(raw[7][d]) * w1[3]);
                            *(LAS u32x4*)(L + O_XWT + (n0 + 2 * d) * RSS + i0 * 2) = lo;
                            *(LAS u32x4*)(L + O_XWT + (n0 + 2 * d + 1) * RSS + i0 * 2) = hi;
                        }
                    }
                }
            }
            if (wave == 7 && ci + 1 < 33) ssd_scal(dtn, ci + 1, dtb, a_neg, sc + ((ci + 1) & 1) * 192, lane);
            if (ci > 1) ssd_writeout(L + O_YB + wl * RSN + wc8 * 4, zw, Y + ((size_t)b * SEQ + (ci - 2) * 64 + wl) * D + head * 64 + wc8);
            if (wave >= 4) {
                if (cstep > 0) { const int ib = ((cstep - 1) * 8 + wave) * F.G + F.vb; if (ib < W2_BLOCKS) w2_commit(W2T, ib, lane, cb0); }
                { const int ib = (cstep * 8 + wave) * F.G + F.vb; if (ib < W2_BLOCKS) w2_issue(W2, ib, lane, cb0); }
            }
            __syncthreads();
            if (cv && ci + 1 < 33) {
#pragma unroll
                for (int i = 0; i < 8; ++i) raw[i] = *(const u32x4*)(XS + (size_t)seq_row(b, (ci + 1) * 64 - 48 + i0 + i) * 4096 + cc);
            }
            if (ci > 0) zw = *(const u32x4*)(P + ((size_t)b * SEQ + (ci - 1) * 64 + wl) * NP + OZ + head * 64 + wc8);
            if (wave == 7 && ci + 2 < 33) dtn = ssd_dtload(DT, b, head, ci + 2, lane);
            if (wave < 4) {
                if (wave < 3) {
                    const int lb = wave > 0 ? 1 : 0, sb = wave == 2 ? 1 : 0;
                    f32x16 acc;
#pragma unroll
                    for (int j = 0; j < 16; ++j) acc[j] = 0.f;
                    const LAS unsigned char* ap = L + O_CM + (lb * 32 + r) * RSN + h * 16;
                    const LAS unsigned char* bp = L + O_BM + (sb * 32 + r) * RSN + h * 16;
#pragma unroll
                    for (int k = 0; k < 8; ++k) acc = __builtin_amdgcn_mfma_f32_32x32x16_bf16(*(const LAS bf16x8*)(ap + k * 32), *(const LAS bf16x8*)(bp + k * 32), acc, 0, 0, 0);
                    const int s = sb * 32 + r; const float acs = scc[s], dts = scc[64 + s];
#pragma unroll
                    for (int g = 0; g < 4; ++g) {
                        const int lbase = lb * 32 + 8 * g + 4 * h;
                        const f32x4 acl = *(const LAS f32x4*)(scc + lbase);
#pragma unroll
                        for (int e = 0; e < 4; ++e) { const int l = lbase + e; const float v = (s <= l) ? acc[g * 4 + e] * __expf(acl[e] - acs) * dts : 0.f;
                            *(LAS unsigned short*)(L + O_MM + l * RSS + s * 2) = f2bf(v); }
                    }
                }
                {
                    const int pb = wave & 1, nb0 = (wave >> 1) * 2;
                    const float dec = __expf(scc[63]);
#pragma unroll
                    for (int j = 0; j < 16; ++j) { st0[j] *= dec; st1[j] *= dec; }
                    const LAS unsigned char* ap = L + O_XWT + (pb * 32 + r) * RSS + h * 16;
                    const LAS unsigned char* bp0 = L + O_BMT + (nb0 * 32 + r) * RSS + h * 16;
                    const LAS unsigned char* bp1 = bp0 + 32 * RSS;
#pragma unroll
                    for (int k = 0; k < 4; ++k) {
                        const bf16x8 a = *(const LAS bf16x8*)(ap + k * 32);
                        st0 = __builtin_amdgcn_mfma_f32_32x32x16_bf16(a, *(const LAS bf16x8*)(bp0 + k * 32), st0, 0, 0, 0);
                        st1 = __builtin_amdgcn_mfma_f32_32x32x16_bf16(a, *(const LAS bf16x8*)(bp1 + k * 32), st1, 0, 0, 0);
                    }
#pragma unroll
                    for (int g = 0; g < 4; ++g)
#pragma unroll
                        for (int e = 0; e < 4; ++e) {
                            const int p = pb * 32 + 8 * g + 4 * h + e;
                            *(LAS unsigned short*)(L + stn + p * RSN + (nb0 * 32 + r) * 2) = f2bf(st0[g * 4 + e]);
                            *(LAS unsigned short*)(L + stn + p * RSN + (nb0 * 32 + 32 + r) * 2) = f2bf(st1[g * 4 + e]);
                        }
                }
            } else {
                const int q = wave - 4, lb = q >> 1, pb = q & 1;
#pragma unroll
                for (int j = 0; j < 16; ++j) st0[j] = 0.f;
                const LAS unsigned char* ap = L + O_CM + (lb * 32 + r) * RSN + h * 16;
                const LAS unsigned char* bp = L + stc + (pb * 32 + r) * RSN + h * 16;
#pragma unroll
                for (int k = 0; k < 8; ++k) st0 = __builtin_amdgcn_mfma_f32_32x32x16_bf16(*(const LAS bf16x8*)(ap + k * 32), *(const LAS bf16x8*)(bp + k * 32), st0, 0, 0, 0);
#pragma unroll
                for (int g = 0; g < 4; ++g) {
                    const f32x4 acl = *(const LAS f32x4*)(scc + lb * 32 + 8 * g + 4 * h);
#pragma unroll
                    for (int e = 0; e < 4; ++e) st0[g * 4 + e] *= __expf(acl[e]);
                }
            }
            __syncthreads();
            if (wave < 4) {
                if (cstep > 0) { const int ib = ((cstep - 1) * 8 + wave) * F.G + F.vb; if (ib < W2_BLOCKS) w2_commit(W2T, ib, lane, cb0); }
                { const int ib = (cstep * 8 + wave) * F.G + F.vb; if (ib < W2_BLOCKS) w2_issue(W2, ib, lane, cb0); }
            }
            ++cstep;
            if (wave >= 4) {
                const int q = wave - 4, lb = q >> 1, pb = q & 1;
                const LAS unsigned char* ap = L + O_MM + (lb * 32 + r) * RSS + h * 16;
                const LAS unsigned char* bp = L + O_XST + (pb * 32 + r) * RSS + h * 16;
#pragma unroll
                for (int k = 0; k < 4; ++k) if (k < 2 * (lb + 1)) st0 = __builtin_amdgcn_mfma_f32_32x32x16_bf16(*(const LAS bf16x8*)(ap + k * 32), *(const LAS bf16x8*)(bp + k * 32), st0, 0, 0, 0);
                if (ci > 0) {
                    const int p = pb * 32 + r;
#pragma unroll
                    for (int g = 0; g < 4; ++g)
#pragma unroll
                        for (int e = 0; e < 4; ++e) {
                            const int l = lb * 32 + 8 * g + 4 * h + e;
                            const float xs = bf2f(*(const LAS unsigned short*)(L + O_XST + p * RSS + l * 2));
                            *(LAS float*)(L + O_YB + l * RSN + p * 4) = st0[g * 4 + e] + dsk * xs;
                        }
                }
            }
            __syncthreads();
        }
        {
            const int wl = tid >> 3, wc8 = (tid & 7) * 8;
            ssd_writeout(L + O_YB + wl * RSN + wc8 * 4, zw, Y + ((size_t)b * SEQ + 31 * 64 + wl) * D + head * 64 + wc8);
            __syncthreads();
        }
    }
    {
        if (cstep > 0) { const int ib = ((cstep - 1) * 8 + wave) * F.G + F.vb; if (ib < W2_BLOCKS) w2_commit(W2T, ib, lane, cb0); }
        for (int st = cstep; (st * 8 + wave) * F.G + F.vb < W2_BLOCKS; ++st) { const int ib = (st * 8 + wave) * F.G + F.vb; w2_issue(W2, ib, lane, cb0); w2_commit(W2T, ib, lane, cb0); }
    }
}

__device__ void p3_lru_meta(const Frame& F) {
    const bf16_t* XR = (const bf16_t*)(F.ws + WS_XR);
    const bf16_t* W = (const bf16_t*)(F.ws + WS_WLRU);
    bf16_t* LOGA = (bf16_t*)(F.ws + WS_LOGA); bf16_t* LU = (bf16_t*)(F.ws + WS_LU);
    const float* ba = F.in[I_LRU_BA]; const float* bx = F.in[I_LRU_BX]; const float* lam = F.in[I_LRU_LAMBDA];
    const int r = F.lane & 31, h = F.lane >> 5;
    for (int it = F.vb * 8 + F.wave; it < 64; it += F.G * 8) {
        const int head = it >> 3, c32 = it & 7;
        const bf16_t* ap = XR + (size_t)(T + (r < NMETA ? r : 0)) * D + head * 256 + 8 * h;
        const bf16_t* bpr = W + ((size_t)head * 512 + (c32 >> 2) * 256 + (c32 & 3) * 32 + r) * 256 + 8 * h;
        const bf16_t* bpi = bpr + 128 * 256;
        f32x16 ar, ai;
#pragma unroll
        for (int j = 0; j < 16; ++j) { ar[j] = 0.f; ai[j] = 0.f; }
#pragma unroll
        for (int k0 = 0; k0 < 256; k0 += 16) {
            const bf16x8 a = *(const bf16x8*)(ap + k0);
            ar = __builtin_amdgcn_mfma_f32_32x32x16_bf16(a, *(const bf16x8*)(bpr + k0), ar, 0, 0, 0);
            ai = __builtin_amdgcn_mfma_f32_32x32x16_bf16(a, *(const bf16x8*)(bpi + k0), ai, 0, 0, 0);
        }
        const int ch = head * 256 + c32 * 32 + r;
        const float bav = ba[ch], bxv = bx[ch], spl = -8.0f * softplusf_(-lam[ch]);
#pragma unroll
        for (int j = 0; j < 8; ++j) {
            const int row = (j & 3) + 8 * (j >> 2) + 4 * h;
            const size_t off = (size_t)(T + row) * D + ch;
            const float l = spl * sigmoidf_(ar[j] + bav);
            const float u = sqrtf(fmaxf(1.0f - __expf(2.0f * l), 0.0f)) * sigmoidf_(ai[j] + bxv) * bf2f(XR[off]);
            LOGA[off] = f2bf(l); LU[off] = f2bf(u);
        }
    }
}

__device__ void p3_ssd_norm(const Frame& F) {
    const bf16_t* Y = (const bf16_t*)(F.ws + WS_YSSD);
    bf16_t* YN = (bf16_t*)(F.ws + WS_YSSDN);
    const float* nw = F.in[I_SSD_NORM];
    const int half = F.lane >> 5, l32 = F.lane & 31;
    for (int it0 = (F.vb * 8 + F.wave) * 16; it0 < T * NGRP; it0 += F.G * 8 * 16) {
        u32x4 w[8]; float ss[8];
#pragma unroll
        for (int q = 0; q < 8; ++q) { const int it = it0 + q * 2 + half; w[q] = *(const u32x4*)(Y + (size_t)(it >> 3) * D + (it & 7) * 256 + l32 * 8); }
#pragma unroll
        for (int q = 0; q < 8; ++q) {
            const float v[8] = {bflo(w[q].x), bfhi(w[q].x), bflo(w[q].y), bfhi(w[q].y), bflo(w[q].z), bfhi(w[q].z), bflo(w[q].w), bfhi(w[q].w)};
            float a = 0.f;
#pragma unroll
            for (int j = 0; j < 8; ++j) a += v[j] * v[j];
            ss[q] = a;
        }
#pragma unroll
        for (int o = 16; o > 0; o >>= 1) {
#pragma unroll
            for (int q = 0; q < 8; ++q) ss[q] += __shfl_xor(ss[q], o);
        }
#pragma unroll
        for (int q = 0; q < 8; ++q) {
            const int it = it0 + q * 2 + half, g = it & 7;
            const float rstd = rsqrtf(ss[q] * (1.0f / 256.0f) + EPS);
            const f32x4 g0 = *(const f32x4*)(nw + g * 256 + l32 * 8), g1 = *(const f32x4*)(nw + g * 256 + l32 * 8 + 4);
            u32x4 o;
            o.x = cvt_pk_bf16(bflo(w[q].x) * rstd * g0[0], bfhi(w[q].x) * rstd * g0[1]); o.y = cvt_pk_bf16(bflo(w[q].y) * rstd * g0[2], bfhi(w[q].y) * rstd * g0[3]);
            o.z = cvt_pk_bf16(bflo(w[q].z) * rstd * g1[0], bfhi(w[q].z) * rstd * g1[1]); o.w = cvt_pk_bf16(bflo(w[q].w) * rstd * g1[2], bfhi(w[q].w) * rstd * g1[3]);
            *(u32x4*)(YN + (size_t)(it >> 3) * D + g * 256 + l32 * 8) = o;
        }
    }
}

__device__ void p4_lru_scan(const Frame& F) {
    const bf16_t* LA = (const bf16_t*)(F.ws + WS_LOGA);
    const bf16_t* LU = (const bf16_t*)(F.ws + WS_LU);
    const bf16_t* P = (const bf16_t*)(F.ws + WS_PROJ);
    bf16_t* YL = (bf16_t*)(F.ws + WS_YLRU);
    LAS float* sP = (LAS float*)F.lds;
    LAS float* sH = sP + 4096;
    const int cgp = F.tid & 7, seg = F.tid >> 3;
    const int t_lo = seg == 0 ? 0 : NMETA + 32 * seg, t_hi = NMETA + 32 + 32 * seg;
    for (int unit = F.vb; unit < NBATCH * 32; unit += F.G) {
        const int b = unit >> 5, ch0 = (unit & 31) * 64 + cgp * 8;
        float Hh[8], Pp[8];
#pragma unroll
        for (int j = 0; j < 8; ++j) { Hh[j] = 0.f; Pp[j] = 0.f; }
#pragma unroll 4
        for (int t = t_lo; t < t_hi; ++t) {
            const size_t off = (size_t)seq_row(b, t) * D + ch0;
            const u32x4 aw = *(const u32x4*)(LA + off), uw = *(const u32x4*)(LU + off);
            const float la[8] = {bflo(aw.x), bfhi(aw.x), bflo(aw.y), bfhi(aw.y), bflo(aw.z), bfhi(aw.z), bflo(aw.w), bfhi(aw.w)};
            const float uu[8] = {bflo(uw.x), bfhi(uw.x), bflo(uw.y), bfhi(uw.y), bflo(uw.z), bfhi(uw.z), bflo(uw.w), bfhi(uw.w)};
#pragma unroll
            for (int j = 0; j < 8; ++j) { Hh[j] = __expf(la[j]) * Hh[j] + uu[j]; Pp[j] += la[j]; }
        }
#pragma unroll
        for (int j = 0; j < 8; ++j) { sP[seg * 64 + cgp * 8 + j] = Pp[j]; sH[seg * 64 + cgp * 8 + j] = Hh[j]; }
        __syncthreads();
        if (F.tid < 64) {
            float car = 0.f;
            for (int s2 = 0; s2 < 64; ++s2) { const float pp = sP[s2 * 64 + F.tid], hh = sH[s2 * 64 + F.tid]; sH[s2 * 64 + F.tid] = car; car = __expf(pp) * car + hh; }
        }
        __syncthreads();
#pragma unroll
        for (int j = 0; j < 8; ++j) Hh[j] = sH[seg * 64 + cgp * 8 + j];
        int t = t_lo;
        for (; t < NMETA && t < t_hi; ++t) {
            const size_t off = (size_t)seq_row(b, t) * D + ch0;
            const u32x4 aw = *(const u32x4*)(LA + off), uw = *(const u32x4*)(LU + off);
            const float la[8] = {bflo(aw.x), bfhi(aw.x), bflo(aw.y), bfhi(aw.y), bflo(aw.z), bfhi(aw.z), bflo(aw.w), bfhi(aw.w)};
            const float uu[8] = {bflo(uw.x), bfhi(uw.x), bflo(uw.y), bfhi(uw.y), bflo(uw.z), bfhi(uw.z), bflo(uw.w), bfhi(uw.w)};
#pragma unroll
            for (int j = 0; j < 8; ++j) Hh[j] = __expf(la[j]) * Hh[j] + uu[j];
        }
#pragma unroll 4
        for (; t < t_hi; ++t) {
            const int row = b * SEQ + (t - NMETA);
            const size_t off = (size_t)row * D + ch0;
            const u32x4 aw = *(const u32x4*)(LA + off), uw = *(const u32x4*)(LU + off), gw = *(const u32x4*)(P + (size_t)row * NP + OLY + ch0);
            const float la[8] = {bflo(aw.x), bfhi(aw.x), bflo(aw.y), bfhi(aw.y), bflo(aw.z), bfhi(aw.z), bflo(aw.w), bfhi(aw.w)};
            const float uu[8] = {bflo(uw.x), bfhi(uw.x), bflo(uw.y), bfhi(uw.y), bflo(uw.z), bfhi(uw.z), bflo(uw.w), bfhi(uw.w)};
#pragma unroll
            for (int j = 0; j < 8; ++j) Hh[j] = __expf(la[j]) * Hh[j] + uu[j];
            u32x4 w; w.x = cvt_pk_bf16(Hh[0] * bflo(gw.x), Hh[1] * bfhi(gw.x)); w.y = cvt_pk_bf16(Hh[2] * bflo(gw.y), Hh[3] * bfhi(gw.y));
            w.z = cvt_pk_bf16(Hh[4] * bflo(gw.z), Hh[5] * bfhi(gw.z)); w.w = cvt_pk_bf16(Hh[6] * bflo(gw.w), Hh[7] * bfhi(gw.w));
            *(u32x4*)(YL + off) = w;
        }
        __syncthreads();
    }
}

__device__ void p7_router(const Frame& F) {
    const float* H1 = (const float*)(F.ws + WS_H1);
    bf16_t* U2 = (bf16_t*)(F.ws + WS_U2);
    const float* g = F.in[I_NORM_FFN];
    const bf16_t* WH = (const bf16_t*)(F.ws + WS_WRH); const bf16_t* WL = (const bf16_t*)(F.ws + WS_WRL);
    unsigned* cnt = (unsigned*)(F.ws + WS_CTL) + CW_CNT;
    int* list = (int*)(F.ws + WS_LIST); float* gate = (float*)(F.ws + WS_GATE);
    LAS float* rs = (LAS float*)F.lds;
    LAS float* part = rs + 64;
    LAS int* hc = (LAS int*)(F.lds + LDS_WORK - 1024);
    LAS int* hb = hc + 64;
    const int lane = F.lane, r = lane & 31, h = lane >> 5;
    LAS float* gl = (LAS float*)(F.lds + 104 * 1024);
    for (int i = F.tid; i < D / 4; i += NTHREADS) *(LAS f32x4*)(gl + 4 * i) = *(const f32x4*)(g + 4 * i);
    __syncthreads();
    for (int tile = F.vb; tile < T / 64; tile += F.G) {
        const int row0 = tile * 64;
        {
            constexpr int RSK = 272;
            LAS unsigned char* Lb = (LAS unsigned char*)part;
            LAS unsigned char* AH = Lb, *AL = AH + 64 * RSK, *BH = AL + 64 * RSK, *BL = BH + 96 * RSK;
            const int mt = F.wave & 1, ks = F.wave >> 1;
            const int arow = F.tid >> 3, aseg = F.tid & 7;
            float ssq = 0.f;
            bf16_t* udst = U2 + (size_t)(row0 + arow) * D + aseg * 16;
            const float* asrc = H1 + (size_t)(row0 + arow) * D + aseg * 16;
            const float* gsrc = g + aseg * 16;
            f32x16 acc[3];
#pragma unroll
            for (int nt = 0; nt < 3; ++nt)
#pragma unroll
                for (int j = 0; j < 16; ++j) acc[nt][j] = 0.f;
#define P7_LDA(c, RA) do { _Pragma("unroll") for (int i = 0; i < 4; ++i) RA[i] = *(const f32x4*)(asrc + (c) * 128 + 4 * i); } while (0)
#define P7_LDB(c) do { _Pragma("unroll") for (int i = 0; i < 3; ++i) { const int pc = F.tid + 512 * i, br = pc >> 4, bs = pc & 15; rbh[i] = *(const u32x4*)(WH + (size_t)br * D + (c) * 128 + bs * 8); rbl[i] = *(const u32x4*)(WL + (size_t)br * D + (c) * 128 + bs * 8); } } while (0)
#define P7_STEP(c, RA) do { \
                _Pragma("unroll") for (int i = 0; i < 2; ++i) { \
                    const f32x4 g0 = *(const LAS f32x4*)(gl + (c) * 128 + aseg * 16 + 8 * i), g1 = *(const LAS f32x4*)(gl + (c) * 128 + aseg * 16 + 8 * i + 4); \
                    float v[8]; \
                    _Pragma("unroll") for (int j = 0; j < 4; ++j) { v[j] = RA[2 * i][j] * g0[j]; v[4 + j] = RA[2 * i + 1][j] * g1[j]; ssq += RA[2 * i][j] * RA[2 * i][j] + RA[2 * i + 1][j] * RA[2 * i + 1][j]; } \
                    u32x4 hw, lw; \
                    hw.x = cvt_pk_bf16(v[0], v[1]); hw.y = cvt_pk_bf16(v[2], v[3]); hw.z = cvt_pk_bf16(v[4], v[5]); hw.w = cvt_pk_bf16(v[6], v[7]); \
                    lw.x = cvt_pk_bf16(v[0] - bflo(hw.x), v[1] - bfhi(hw.x)); lw.y = cvt_pk_bf16(v[2] - bflo(hw.y), v[3] - bfhi(hw.y)); \
                    lw.z = cvt_pk_bf16(v[4] - bflo(hw.z), v[5] - bfhi(hw.z)); lw.w = cvt_pk_bf16(v[6] - bflo(hw.w), v[7] - bfhi(hw.w)); \
                    *(LAS u32x4*)(AH + arow * RSK + aseg * 32 + i * 16) = hw; *(LAS u32x4*)(AL + arow * RSK + aseg * 32 + i * 16) = lw; \
                    *(u32x4*)(udst + (c) * 128 + i * 8) = hw;   \
                } \
                _Pragma("unroll") for (int i = 0; i < 3; ++i) { const int pc = F.tid + 512 * i, br = pc >> 4, bs = pc & 15; *(LAS u32x4*)(BH + br * RSK + bs * 16) = rbh[i]; *(LAS u32x4*)(BL + br * RSK + bs * 16) = rbl[i]; } \
                __syncthreads(); \
                if ((c) + 1 < 16) P7_LDB((c) + 1);      \
                if ((c) + 2 < 16) P7_LDA((c) + 2, RA);   \
                _Pragma("unroll") for (int kk = 0; kk < 2; ++kk) { \
                    const int ko = (ks * 2 + kk) * 32 + h * 16; \
                    const bf16x8 ah = *(const LAS bf16x8*)(AH + (mt * 32 + r) * RSK + ko), al = *(const LAS bf16x8*)(AL + (mt * 32 + r) * RSK + ko); \
                    _Pragma("unroll") for (int nt = 0; nt < 3; ++nt) { \
                        const bf16x8 bhv = *(const LAS bf16x8*)(BH + (nt * 32 + r) * RSK + ko), blv = *(const LAS bf16x8*)(BL + (nt * 32 + r) * RSK + ko); \
                        acc[nt] = __builtin_amdgcn_mfma_f32_32x32x16_bf16(ah, bhv, acc[nt], 0, 0, 0); \
                        acc[nt] = __builtin_amdgcn_mfma_f32_32x32x16_bf16(al, bhv, acc[nt], 0, 0, 0); \
                        acc[nt] = __builtin_amdgcn_mfma_f32_32x32x16_bf16(ah, blv, acc[nt], 0, 0, 0); \
                    } \
                } \
                __syncthreads(); } while (0)
            f32x4 ra0[4], ra1[4]; u32x4 rbh[3], rbl[3];
            P7_LDA(0, ra0); P7_LDB(0); P7_LDA(1, ra1);
#pragma unroll 1
            for (int c = 0; c < 16; c += 2) { P7_STEP(c, ra0); P7_STEP(c + 1, ra1); }
#undef P7_LDA
#undef P7_LDB
#undef P7_STEP
#pragma unroll
            for (int nt = 0; nt < 3; ++nt)
#pragma unroll
                for (int j = 0; j < 16; ++j) { const int tok = mt * 32 + (j & 3) + 8 * (j >> 2) + 4 * h; part[(ks * 64 + tok) * 97 + nt * 32 + r] = acc[nt][j]; }
            ssq += __shfl_xor(ssq, 1); ssq += __shfl_xor(ssq, 2); ssq += __shfl_xor(ssq, 4);
            if (aseg == 0) { const float rstd = rsqrtf(ssq * (1.0f / D) + EPS); rs[arow] = rstd; ((float*)(F.ws + WS_RSTD))[row0 + arow] = rstd; }
        }
        __syncthreads();
        if (F.tid < 64) {
            const LAS float* p0 = part + F.tid * 97;
            const float rsv = rs[F.tid];
            float l[8];
#pragma unroll
            for (int j = 0; j < 8; ++j) l[j] = rsv * ((p0[j] + p0[64 * 97 + j]) + (p0[128 * 97 + j] + p0[192 * 97 + j]));
            int gi = 0; float gm = l[0];
#pragma unroll
            for (int j = 1; j < 8; ++j) if (l[j] > gm) { gm = l[j]; gi = j; }
            float gs = 0.f;
#pragma unroll
            for (int j = 0; j < 8; ++j) gs += __expf(l[j] - gm);
            const float gp = 1.0f / gs;
            float el[8];
#pragma unroll
            for (int j = 0; j < 8; ++j) { const int n = 8 + gi * 8 + j; el[j] = rsv * ((p0[n] + p0[64 * 97 + n]) + (p0[128 * 97 + n] + p0[192 * 97 + n])); }
            int i0 = 0; float m0 = el[0];
#pragma unroll
            for (int j = 1; j < 8; ++j) if (el[j] > m0) { m0 = el[j]; i0 = j; }
            int i1 = -1; float m1 = -3.0e38f;
#pragma unroll
            for (int j = 0; j < 8; ++j) if (j != i0 && el[j] > m1) { m1 = el[j]; i1 = j; }
            const float r1 = __expf(m1 - m0), w0 = 1.0f / (1.0f + r1), w1 = r1 * w0;
            const int tokg = row0 + F.tid;
            const int e0 = gi * 8 + i0, e1 = gi * 8 + i1;
            gate[tokg * 2] = gp * w0; gate[tokg * 2 + 1] = gp * w1;
            hc[F.tid] = 0;
            asm volatile("s_waitcnt lgkmcnt(0)" ::: "memory");
            const int lk0 = __hip_atomic_fetch_add(hc + e0, 1, __ATOMIC_RELAXED, __HIP_MEMORY_SCOPE_WORKGROUP);
            const int lk1 = __hip_atomic_fetch_add(hc + e1, 1, __ATOMIC_RELAXED, __HIP_MEMORY_SCOPE_WORKGROUP);
            asm volatile("s_waitcnt lgkmcnt(0)" ::: "memory");
            const int mine = hc[F.tid];
            unsigned basee = 0u;
            if (mine > 0) basee = atomicAdd(&cnt[F.tid], (unsigned)mine);
            hb[F.tid] = (int)basee;
            asm volatile("s_waitcnt lgkmcnt(0)" ::: "memory");
            list[(size_t)e0 * T + hb[e0] + lk0] = tokg * 2; list[(size_t)e1 * T + hb[e1] + lk1] = tokg * 2 + 1;
        }
        __syncthreads();
    }
}

__device__ void moe_tables(const Frame& F, int nN, LAS int* ub, LAS int* tb, LAS int* cl) {
    const unsigned* cnt = (const unsigned*)(F.ws + WS_CTL) + CW_CNT;
    LAS int* us = cl + 80;
    if (F.tid < 64) {
        const int ce = (int)cnt[F.tid]; cl[F.tid] = ce;
        const int mt = (ce + 255) >> 8;
        const int ns = (mt > 0 && ce - ((mt - 1) << 8) <= 128) ? 1 : 0, nl = mt - ns;
        int incl = mt, incL = nl, incS = ns;
#pragma unroll
        for (int o = 1; o < 64; o <<= 1) { const int v = __shfl_up(incl, o), vL = __shfl_up(incL, o), vS = __shfl_up(incS, o); if (F.lane >= o) { incl += v; incL += vL; incS += vS; } }
        tb[F.tid] = incl - mt; ub[F.tid] = (incL - nl) * nN; us[F.tid] = (incS - ns) * nN;
        if (F.tid == 63) { tb[NEXP] = incl; ub[NEXP] = incL * nN; us[NEXP] = incS * nN; }
    }
    __syncthreads();
}

__device__ void p10_final(const Frame& F) {
    const float* H1 = (const float*)(F.ws + WS_H1);
    const bf16_t* Y = (const bf16_t*)(F.ws + WS_Y);
    const float* g = F.in[I_NORM_FINAL];
    for (int row = F.vb * 8 + F.wave; row < T; row += F.G * 8) {
        f32x4 v[8]; float ss = 0.f;
#pragma unroll
        for (int i = 0; i < 8; ++i) {
            const int col = i * 256 + F.lane * 4;
            v[i] = *(const f32x4*)(H1 + (size_t)row * D + col);
            const u32x2 a = *(const u32x2*)(Y + (size_t)(row * 2) * D + col), b = *(const u32x2*)(Y + (size_t)(row * 2 + 1) * D + col);
            v[i][0] += bflo(a.x) + bflo(b.x); v[i][1] += bfhi(a.x) + bfhi(b.x); v[i][2] += bflo(a.y) + bflo(b.y); v[i][3] += bfhi(a.y) + bfhi(b.y);
            ss += v[i][0] * v[i][0] + v[i][1] * v[i][1] + v[i][2] * v[i][2] + v[i][3] * v[i][3];
        }
        ss = wave_sum(ss);
        const float rstd = rsqrtf(ss * (1.0f / D) + EPS);
#pragma unroll
        for (int i = 0; i < 8; ++i) {
            const int col = i * 256 + F.lane * 4;
            const f32x4 gg = *(const f32x4*)(g + col);
            f32x4 o; o[0] = v[i][0] * rstd * gg[0]; o[1] = v[i][1] * rstd * gg[1]; o[2] = v[i][2] * rstd * gg[2]; o[3] = v[i][3] * rstd * gg[3];
            *(f32x4*)(F.out + (size_t)row * D + col) = o;
        }
    }
}


typedef __attribute__((address_space(4))) const Args* KArgsPtr;
__device__ __forceinline__ Frame refresh(const Frame& F0) {
    Frame F = F0;
    int t = threadIdx.x; asm volatile("" : "+v"(t));
    F.tid = t; F.lane = t & 63; F.wave = __builtin_amdgcn_readfirstlane(t >> 6);
    KArgsPtr ap = (KArgsPtr)__builtin_amdgcn_kernarg_segment_ptr(); asm volatile("" : "+s"(ap));
#pragma unroll
    for (int i = 0; i < 28; ++i) F.in[i] = ap->in[i];
    F.out = ap->out; F.ws = ap->ws;
    return F;
}
__device__ __forceinline__ void ph1(const Frame& F) {
    pg8::DenseSched S; S.init(F.ws + WS_U, D * 2, F.ws + WS_WIN, D, T / 256, NP / 256, F.G, F.vb);
    EpiProj E{(bf16_t*)(F.ws + WS_PROJ), F.in[I_GATE_BIAS]};
    pg8::gemm_phase<EpiProj, pg8::DenseSched, false>(F.lds, D, S, E);
    p1_thin(F);
}
__device__ __forceinline__ void ph3(const Frame& F) {
    p2_ssd_chunk(F);
    pg8::DenseSched S; S.init(F.ws + WS_XR, D * 2, F.ws + WS_WLRU, 256, 64, 16, F.G, F.vb, 512);
    EpiLru E{(const bf16_t*)(F.ws + WS_XR), (bf16_t*)(F.ws + WS_LOGA), (bf16_t*)(F.ws + WS_LU), F.in[I_LRU_BA], F.in[I_LRU_BX], F.in[I_LRU_LAMBDA]};
    pg8::gemm_phase<EpiLru, pg8::DenseSched, false>(F.lds, 256, S, E);
    p3_lru_meta(F);
}
__device__ __forceinline__ void ph4(const Frame& F) { p4_lru_scan(F); p3_ssd_norm(F); }
__device__ __forceinline__ void ph5(const Frame& F) {
    pg8::PairSched S; S.init(F.ws + WS_YSSDN, F.ws + WS_YLRU, D * 2, F.ws + WS_WSO, F.ws + WS_WLO, D, T / 256, D / 256, F.G, F.vb);
    EpiMixPair E{(const bf16_t*)(F.ws + WS_PROJ), (bf16_t*)(F.ws + WS_MIXED)};
    pg8::gemm_phase<EpiMixPair, pg8::PairSched, false, false, true>(F.lds, D, S, E);
}
__device__ __forceinline__ void ph6(const Frame& F) {
    pg8::DenseSched S; S.init(F.ws + WS_MIXED, D * 2, F.ws + WS_WOUT, D, T / 256, D / 256, F.G, F.vb);
    EpiRes E{F.in[I_X], (float*)(F.ws + WS_H1)};
    pg8::gemm_phase<EpiRes, pg8::DenseSched, false>(F.lds, D, S, E);
}
__device__ __forceinline__ void ph8(const Frame& F) {
    LAS int* ub = (LAS int*)(F.lds + MISC_OFF + 256); LAS int* tb = ub + 80; LAS int* cl = tb + 80;
    moe_tables(F, FF / 128, ub, tb, cl);
    pg8::MoeSched S; S.A = (const char*)(F.ws + WS_U2); S.W0 = (const char*)F.in[I_W_EG]; S.W1 = (const char*)F.in[I_W_EU]; S.list = (const int*)(F.ws + WS_LIST); S.ub = ub; S.us = cl + 80; S.tb = tb; S.cl = cl;
    S.rowval = (const float*)(F.ws + WS_RSTD); S.valshift = 1; S.rowtbl = F.lds + MOE_ROWTBL_OFF;
    S.lda = D * 2; S.K = D; S.nN = FF / 128; S.G = F.G; S.c = F.vb; S.gather = 1; S.ldb = FF * 4; S.cpn = 128 * 4; S.bstride = (size_t)D * FF * 4;
    EpiMoe1 E{(bf16_t*)(F.ws + WS_HDN), F.lds + MOE_ROWTBL_OFF};
    pg8::gemm_phase<EpiMoe1, pg8::MoeSched, true, true, false, true, true>(F.lds, D, S, E);
}
__device__ __forceinline__ void ph9(const Frame& F) {
    LAS int* ub = (LAS int*)(F.lds + MISC_OFF + 256); LAS int* tb = ub + 80; LAS int* cl = tb + 80;
    static_assert(FF / 128 == D / 256, "the MoE down phase reuses the unit tables of the MoE up phase");
#if MK_N_LAUNCHES != 1
    moe_tables(F, D / 256, ub, tb, cl);
#endif
    pg8::MoeSched S; S.A = (const char*)(F.ws + WS_HDN); S.W0 = (const char*)(F.ws + WS_W2); S.W1 = S.W0; S.list = (const int*)(F.ws + WS_LIST); S.ub = ub; S.us = cl + 80; S.tb = tb; S.cl = cl;
    S.rowval = (const float*)(F.ws + WS_GATE); S.valshift = 0; S.rowtbl = F.lds + MOE_ROWTBL_OFF;
    S.lda = FF * 2; S.K = FF; S.nN = D / 256; S.G = F.G; S.c = F.vb; S.gather = 0; S.ldb = 0; S.cpn = 256 * FF * 2; S.bstride = (size_t)D * FF * 2;
    EpiMoe2 E{(bf16_t*)(F.ws + WS_Y), F.lds + MOE_ROWTBL_OFF};
    pg8::gemm_phase<EpiMoe2, pg8::MoeSched, false, false, false, true, true>(F.lds, FF, S, E);
}

constexpr int N_PHASES = 11;
__global__ void __launch_bounds__(NTHREADS, 2) fwd(Args args) {
    extern __shared__ __attribute__((aligned(16))) unsigned char lds_raw[];
    Frame F0;
    F0.lds = (LAS unsigned char*)lds_raw;
    F0.tid = threadIdx.x; F0.lane = F0.tid & 63; F0.wave = __builtin_amdgcn_readfirstlane(F0.tid >> 6);
    F0.G = gridDim.x; F0.vb = blockIdx.x;
#pragma unroll
    for (int i = 0; i < 28; ++i) F0.in[i] = args.in[i];
    F0.out = args.out; F0.ws = args.ws;
    volatile LAS unsigned* MISC = (volatile LAS unsigned*)(F0.lds + MISC_OFF);
    if (threadIdx.x < 4) MISC[threadIdx.x] = 0u;
    __syncthreads();
    const int lo = args.ph_lo, hi = args.ph_hi;
    XcdBarrier bar; bar.bar = (unsigned*)(args.ws + WS_CTL) + CW_BAR; bar.x = 0; bar.st = MISC;
    if (hi - lo > 1) bar = xcd_barrier_post((unsigned*)(args.ws + WS_CTL) + CW_BAR, MISC);
#ifndef PHMASK
#define PHMASK 0x7ff
#endif
#define IN(k) (((PHMASK >> (k)) & 1) && lo <= (k) && (k) < hi)
#define SEAM(k) do { if (IN(k) && IN((k) + 1)) xcd_barrier(bar); } while (0)
#ifndef REPMASK
#define REPMASK 0
#endif

#define RUN(k, call) do { if (IN(k)) { { const Frame F = refresh(F0); call; } if ((REPMASK >> (k)) & 1) { const Frame F = refresh(F0); call; } } } while (0)
    RUN(0, p0_prologue(F));
    SEAM(0);
    RUN(1, ph1(F));
    SEAM(1);
    RUN(2, p2_conv(F));
    SEAM(2);
    RUN(3, ph3(F));
    SEAM(3);
    RUN(4, ph4(F));
    SEAM(4);
    RUN(5, ph5(F));
    SEAM(5);
    RUN(6, ph6(F));
    SEAM(6);
    RUN(7, p7_router(F));
    SEAM(7);
    RUN(8, ph8(F));
    SEAM(8);
    RUN(9, ph9(F));
    SEAM(9);
    RUN(10, p10_final(F));
#undef IN
#undef SEAM
}

extern "C" void kernel_launch(void* const* d_in, const int* in_sizes, int n_in, void* d_out, int out_size, void* d_ws, size_t ws_size, hipStream_t stream) {
    static int grid = 0;
    if (grid == 0) {
        if (n_in != 28 || ws_size < WS_END) { fprintf(stderr, "kernel_launch: unexpected n_in %d / ws_size %zu (need %zu)\n", n_in, ws_size, (size_t)WS_END); grid = -1; return; }
        int dev = 0, cus = 0, per_cu = 0;
        if (hipGetDevice(&dev) != hipSuccess || hipDeviceGetAttribute(&cus, hipDeviceAttributeMultiprocessorCount, dev) != hipSuccess) { grid = -1; return; }
        if (hipFuncSetAttribute((const void*)fwd, hipFuncAttributeMaxDynamicSharedMemorySize, LDS_BYTES) != hipSuccess) { fprintf(stderr, "kernel_launch: hipFuncSetAttribute failed\n"); grid = -1; return; }
        if (hipOccupancyMaxActiveBlocksPerMultiprocessor(&per_cu, (const void*)fwd, NTHREADS, LDS_BYTES) != hipSuccess || per_cu < 1) { fprintf(stderr, "kernel_launch: occupancy query says %d\n", per_cu); }
        (void)hipGetLastError();
        grid = cus;
    }
    if (grid < 0) return;
    (void)hipMemsetAsync((char*)d_ws + WS_CTL, 0, CTL_BYTES, stream);
    Args a; memset(&a, 0, sizeof(a));
    for (int i = 0; i < 28; ++i) a.in[i] = (const float*)d_in[i];
    a.out = (float*)d_out; a.ws = (unsigned char*)d_ws;
#if MK_N_LAUNCHES == 1
    a.ph_lo = 0; a.ph_hi = N_PHASES;
    hipLaunchKernelGGL(fwd, dim3(grid), dim3(NTHREADS), LDS_BYTES, stream, a);
#else
    for (int p = 0; p < N_PHASES; ++p) { a.ph_lo = p; a.ph_hi = p + 1; hipLaunchKernelGGL(fwd, dim3(grid), dim3(NTHREADS), LDS_BYTES, stream, a); }
#endif
}
```

```cpp
#include <hip/hip_runtime.h>
#include <stdint.h>
#include <string.h>
#include <stdio.h>

#ifndef MK_N_LAUNCHES
#define MK_N_LAUNCHES 1
#endif

#define LAS __attribute__((address_space(3)))
typedef unsigned short bf16_t;
typedef short bf16x8 __attribute__((ext_vector_type(8)));
typedef float f32x4 __attribute__((ext_vector_type(4)));
typedef float f32x2 __attribute__((ext_vector_type(2)));
typedef float f32x16 __attribute__((ext_vector_type(16)));
typedef unsigned u32x4 __attribute__((ext_vector_type(4)));
typedef unsigned u32x2 __attribute__((ext_vector_type(2)));

constexpr int D = 2048, NBATCH = 8, SEQ = 2048, NMETA = 16;
constexpr int T = NBATCH * SEQ;
constexpr int TR = T + NMETA;
constexpr int TRP = 65 * 256;
constexpr int NP = 14336;
constexpr int OZ = 0, OXBC = 2048, OLX = 6144, OLY = 8192, OGL = 10240;
constexpr int NHEAD = 32, HD = 64, NGRP = 8, NST = 128;
constexpr int NEXP = 64, FF = 1024;
constexpr float EPS = 1e-6f;
constexpr int NTHREADS = 512;

constexpr size_t MiB = 1024 * 1024;
constexpr size_t WS_CTL = 0;
constexpr size_t CTL_BYTES = 64 * 1024;
constexpr size_t CW_BAR = 0;
constexpr size_t CW_CNT = 4096;
constexpr size_t WS_LIST = 1 * MiB;
constexpr size_t WS_GATE = WS_LIST + 4 * MiB;
constexpr size_t WS_RSTD = WS_GATE + 128 * 1024;
constexpr size_t WS_WRH = WS_GATE + 256 * 1024;
constexpr size_t WS_WRL = WS_GATE + 640 * 1024;
constexpr size_t WS_DT = WS_GATE + 1 * MiB;
constexpr size_t WS_WIN = WS_DT + 3 * MiB;
constexpr size_t WS_WSO = WS_WIN + 57 * MiB;
constexpr size_t WS_WLO = WS_WSO + 8 * MiB;
constexpr size_t WS_WOUT = WS_WLO + 8 * MiB;
constexpr size_t WS_WLRU = WS_WOUT + 8 * MiB;
constexpr size_t WS_W13 = WS_WLRU + 2 * MiB;
constexpr size_t WS_W2 = WS_W13 + 512 * MiB;
constexpr size_t WS_U = WS_W2 + 256 * MiB;
constexpr size_t WS_XR = WS_U + 65 * MiB;
constexpr size_t WS_LOGA = WS_XR + 65 * MiB;
constexpr size_t WS_LU = WS_LOGA + 65 * MiB;
constexpr size_t WS_YSSD = WS_LU + 65 * MiB;
constexpr size_t WS_YSSDN = WS_YSSD + 64 * MiB;
constexpr size_t WS_YLRU = WS_YSSDN + 64 * MiB;
constexpr size_t WS_PROJ = WS_YLRU + 64 * MiB;
constexpr size_t WS_XBCS = WS_PROJ + 455 * MiB;
constexpr size_t WS_END = WS_XBCS + 130 * MiB;
constexpr size_t WS_T1 = WS_U;
constexpr size_t WS_MIXED = WS_LOGA;
constexpr size_t WS_H1 = WS_LU;
constexpr size_t WS_U2 = WS_YSSDN;
constexpr size_t WS_HDN = WS_PROJ;
constexpr size_t WS_Y = WS_PROJ + 96 * MiB;
static_assert(WS_END <= 2048 * MiB, "workspace");
static_assert((size_t)14368 * 2048 * 2 <= 57 * MiB && (size_t)TRP * 2048 * 2 <= 65 * MiB && (size_t)TRP * NP * 2 <= 455 * MiB, "sizes");

typedef __bf16 bf16x2_t __attribute__((ext_vector_type(2)));
__device__ __forceinline__ unsigned cvt_pk_bf16(float lo, float hi) { const f32x2 v = {lo, hi}; const bf16x2_t b = __builtin_convertvector(v, bf16x2_t); return __builtin_bit_cast(unsigned, b); }
__device__ __forceinline__ unsigned short f2bf(float v) { return (unsigned short)(cvt_pk_bf16(v, 0.f) & 0xffffu); }
__device__ __forceinline__ float bf2f(unsigned short b) { return __uint_as_float(((unsigned)b) << 16); }
__device__ __forceinline__ float bflo(unsigned w) { return __uint_as_float(w << 16); }
__device__ __forceinline__ float bfhi(unsigned w) { return __uint_as_float(w & 0xffff0000u); }
__device__ __forceinline__ float sigmoidf_(float x) { return __builtin_amdgcn_rcpf(1.0f + __expf(-x)); }
__device__ __forceinline__ float siluf_(float x) { return x * __builtin_amdgcn_rcpf(1.0f + __expf(-x)); }
__device__ __forceinline__ float gelu_tanh_(float x) { const float y = 1.5957691216f * (x + 0.044715f * x * x * x); return x * __builtin_amdgcn_rcpf(1.0f + __expf(-y)); }
__device__ __forceinline__ float softplusf_(float x) { return fmaxf(x, 0.0f) + __logf(1.0f + __expf(-fabsf(x))); }
__device__ __forceinline__ float wave_sum(float v) {
#pragma unroll
    for (int o = 32; o > 0; o >>= 1) v += __shfl_xor(v, o);
    return v;
}

#define XB_TMO      128
#define XB_XCNT(j)  (256  + 64 * (j))
#define XB_XSUB(j)  (1280 + 64 * (j))
#define XB_XGEN(j)  (2304 + 64 * (j))
#define XB_TOP      3328
#define XB_TOPGEN   3392
#define XCD_BAR_WORDS 3456
#define XB_SPIN_CAP (1u << 22)

__device__ __forceinline__ unsigned xb_ld(unsigned* p)              { return __hip_atomic_load(p, __ATOMIC_RELAXED, __HIP_MEMORY_SCOPE_AGENT); }
__device__ __forceinline__ unsigned xb_add(unsigned* p, unsigned v) { return __hip_atomic_fetch_add(p, v, __ATOMIC_RELAXED, __HIP_MEMORY_SCOPE_AGENT); }
__device__ __forceinline__ unsigned xb_xcc_id() { return (unsigned)__builtin_amdgcn_s_getreg((3 << 11) | 20) & 0xFu; }
#define XB_SPIN(cond, bar) do { unsigned _sp = 0; while (cond) { __builtin_amdgcn_s_sleep(1); \
    if ((++_sp & 255u) == 0u) { if (xb_ld(&(bar)[XB_TMO])) break; if (_sp > XB_SPIN_CAP) { atomicAdd(&(bar)[XB_TMO], 1u); break; } } } } while (0)

struct XcdBarrier { unsigned* bar; unsigned x; volatile LAS unsigned* st; };

__device__ __forceinline__ XcdBarrier xcd_barrier_post(unsigned* bar, volatile LAS unsigned* st) {
    XcdBarrier b; b.bar = bar; b.x = xb_xcc_id(); b.st = st;
    if (threadIdx.x == 0) (void)xb_add(&bar[XB_XCNT(b.x)], 1u);
    return b;
}
__device__ __forceinline__ void xcd_barrier_complete(unsigned* bar, unsigned x, unsigned& nloc, unsigned& nx) {
    const unsigned G = gridDim.x * gridDim.y * gridDim.z;
    unsigned sum, cnt, mine, sp = 0u;
    for (;;) {
        sum = 0u; cnt = 0u; mine = 0u;
#pragma unroll
        for (unsigned j = 0; j < 16; ++j) { const unsigned c = xb_ld(&bar[XB_XCNT(j)]); sum += c; cnt += (c > 0u) ? 1u : 0u; mine = (j == x) ? c : mine; }
        if (sum == G) break;
        __builtin_amdgcn_s_sleep(1);
        if ((++sp & 255u) == 0u) { if (xb_ld(&bar[XB_TMO])) break; if (sp > XB_SPIN_CAP) { atomicAdd(&bar[XB_TMO], 1u); break; } }
    }
    nloc = mine > 0u ? mine : 1u; nx = cnt > 0u ? cnt : 1u;
}
__device__ __forceinline__ void xcd_barrier(const XcdBarrier& b) {
    asm volatile("s_waitcnt vmcnt(0)" ::: "memory");
    __syncthreads();
    if (threadIdx.x == 0) {
        unsigned* bar = b.bar;
        __builtin_amdgcn_s_waitcnt(0);
        unsigned nloc = b.st[0], nx = b.st[1];
        if (nloc == 0u) { xcd_barrier_complete(bar, b.x, nloc, nx); b.st[0] = nloc; b.st[1] = nx; }
        const unsigned old = xb_add(&bar[XB_XSUB(b.x)], 1u);
        const unsigned gen = old / nloc;
        if (old + 1u == (gen + 1u) * nloc) {
            __builtin_amdgcn_fence(__ATOMIC_RELEASE, "agent");
            asm volatile("s_waitcnt vmcnt(0)" ::: "memory");
            const unsigned og = xb_add(&bar[XB_TOP], 1u);
            const unsigned tg = og / nx;
            if (og + 1u == (tg + 1u) * nx) xb_add(&bar[XB_TOPGEN], 1u);
            else XB_SPIN(xb_ld(&bar[XB_TOPGEN]) == tg, bar);
            __builtin_amdgcn_fence(__ATOMIC_ACQUIRE, "agent");
            xb_add(&bar[XB_XGEN(b.x)], 1u);
            asm volatile("s_waitcnt vmcnt(0)" ::: "memory");
        } else {
            XB_SPIN(xb_ld(&bar[XB_XGEN(b.x)]) == gen, bar);
            __builtin_amdgcn_fence(__ATOMIC_ACQUIRE, "agent");
            asm volatile("s_waitcnt vmcnt(0)" ::: "memory");
        }
    }
    __syncthreads();
}

namespace pg8 {
constexpr int BM = 256, BK = 64, HALF = 128, HTB = HALF * BK * 2, STAGE_BYTES = 8 * HTB, NXCD = 8, WGM = 8;
__host__ __device__ __forceinline__ int lds_byte(int r, int c) { const int st = (r >> 4) * 2 + (c >> 5), rr = r & 15, cc = c & 31, ob = rr * 64 + cc * 2; return st * 1024 + (ob ^ (((ob >> 9) & 1) << 5)); }
__host__ __device__ __forceinline__ void stage_rc(int b, int& R, int& C) { const int st = b >> 10, sb = b & 1023, swz = sb ^ (((sb >> 9) & 1) << 5); R = (st >> 1) * 16 + (swz >> 6); C = (st & 1) * 32 + ((swz & 63) >> 1); }
__host__ __device__ __forceinline__ int perm32(int rho) { const int n = rho >> 4, i = rho & 15; return 8 * (i >> 2) + 4 * n + (i & 3); }

struct Unit { const char* A; const char* B; const char* B1; int pm, pn, e, cnt, par; };

struct DenseSched {
    static constexpr int ldb = 0;
    const char* A; const char* B; int lda  , K, nM, nN, nwg, G, c, acb  ;
    __device__ void init(const void* A_, int lda_bytes, const void* B_, int K_, int nM_, int nN_, int G_, int c_, int acb_ = 0) { A = (const char*)A_; B = (const char*)B_; lda = lda_bytes; K = K_; nM = nM_; nN = nN_; nwg = nM * nN; G = G_; c = c_; acb = acb_; }
    __device__ bool next(int i, Unit& u) const {
        const long L = (long)i * G + c; if (L >= nwg) return false;
        int wgid = (int)L; { const int q = nwg / NXCD, r = nwg % NXCD, xcd = wgid % NXCD, off = wgid / NXCD; wgid = (xcd < r ? xcd * (q + 1) : r * (q + 1) + (xcd - r) * q) + off; }
        const int nig = WGM * nN, gid = wgid / nig, fm = gid * WGM, gsz = (nM - fm) < WGM ? (nM - fm) : WGM;
        u.pm = fm + ((wgid % nig) % gsz); u.pn = (wgid % nig) / gsz; u.e = 0; u.cnt = 256; u.par = 0;
        u.A = A + (size_t)u.pm * 256 * lda + (size_t)(u.pn >> 1) * acb; u.B = B + (size_t)u.pn * 256 * K * 2; u.B1 = u.B;
        return true;
    }
    __device__ __forceinline__ void aoffs(const Unit&, const int (&R)[2], const int (&C)[2], unsigned (&v)[4]) const {
#pragma unroll
        for (int h = 0; h < 2; ++h)
#pragma unroll
            for (int i = 0; i < 2; ++i) v[h * 2 + i] = (unsigned)((R[i] + 128 * h) * lda + C[i] * 2);
    }
};

struct PairSched {
    static constexpr int ldb = 0;
    const char* A0; const char* A1; const char* B0; const char* B1; int lda, K, nM, nN, nwg, G, c;
    __device__ void init(const void* A0_, const void* A1_, int lda_bytes, const void* B0_, const void* B1_, int K_, int nM_, int nN_, int G_, int c_) {
        A0 = (const char*)A0_; A1 = (const char*)A1_; B0 = (const char*)B0_; B1 = (const char*)B1_; lda = lda_bytes; K = K_; nM = nM_; nN = nN_; nwg = nM * nN; G = G_; c = c_; }
    __device__ bool next(int i, Unit& u) const {
        const long L = (long)(i >> 1) * G + c; if (L >= nwg) return false;
        int wgid = (int)L; { const int q = nwg / NXCD, r = nwg % NXCD, xcd = wgid % NXCD, off = wgid / NXCD; wgid = (xcd < r ? xcd * (q + 1) : r * (q + 1) + (xcd - r) * q) + off; }
        const int nig = WGM * nN, gid = wgid / nig, fm = gid * WGM, gsz = (nM - fm) < WGM ? (nM - fm) : WGM;
        u.pm = fm + ((wgid % nig) % gsz); u.pn = (wgid % nig) / gsz; u.e = i & 1; u.cnt = 256; u.par = 0;
        u.A = ((i & 1) ? A1 : A0) + (size_t)u.pm * 256 * lda; u.B = ((i & 1) ? B1 : B0) + (size_t)u.pn * 256 * K * 2; u.B1 = u.B;
        return true;
    }
    __device__ __forceinline__ void aoffs(const Unit&, const int (&R)[2], const int (&C)[2], unsigned (&v)[4]) const {
#pragma unroll
        for (int h = 0; h < 2; ++h)
#pragma unroll
            for (int i = 0; i < 2; ++i) v[h * 2 + i] = (unsigned)((R[i] + 128 * h) * lda + C[i] * 2);
    }
};

struct MoeSched {
    const char* A; const char* W0; const char* W1; const int* list; const float* rowval; LAS const int* ub; LAS const int* us; LAS const int* tb; LAS const int* cl; LAS unsigned char* rowtbl;
    int lda, K, nN, G, c, gather, ldb  , cpn  , valshift  ; size_t bstride  ;
    __device__ bool next(int i, Unit& u) const {
        int p = (G & 7) == 0 ? (c & 7) * (G >> 3) + (c >> 3) : c; if (i & 1) p = G - 1 - p;
        const int L = i * G + p, totL = ub[NEXP]; if (L >= totL + us[NEXP]) return false;
        const bool sh = L >= totL; const LAS int* pre = sh ? us : ub; const int Lq = sh ? L - totL : L;
        int lo = 0, hi = NEXP - 1;
        while (lo < hi) { const int mid = (lo + hi + 1) >> 1; if (pre[mid] <= Lq) lo = mid; else hi = mid - 1; }
        const int e = lo, r = Lq - pre[e], mt = tb[e + 1] - tb[e], nl = mt - (us[e + 1] != us[e] ? 1 : 0);
        u.e = e; u.pn = sh ? r : r / nl; const int m = sh ? mt - 1 : r % nl; u.pm = tb[e] + m; u.par = i & 1;
        const int ce = cl[e]; u.cnt = (ce - m * 256) < 256 ? (ce - m * 256) : 256;
        u.B = W0 + (size_t)e * bstride + (size_t)u.pn * cpn; u.B1 = W1 + (size_t)e * bstride + (size_t)u.pn * cpn;
        u.A = gather ? A : A + (size_t)u.pm * 256 * lda;
        return true;
    }
    __device__ __forceinline__ const int* entry_ptr(const Unit& u, int t) const { return list + (size_t)u.e * T + (u.pm - tb[u.e]) * 256 + (t < u.cnt ? t : 0); }
    __device__ __forceinline__ const float* val_ptr(int entry) const { return rowval + (entry >> valshift); }
    __device__ __forceinline__ LAS int* tbl_ent(int par) const { return (LAS int*)(rowtbl + par * 2048); }
    __device__ __forceinline__ LAS float* tbl_val(int par) const { return (LAS float*)(rowtbl + par * 2048 + 1024); }
    __device__ __forceinline__ void aoffs(const Unit& u, const int (&R)[2], const int (&C)[2], unsigned (&v)[4]) const {
        const LAS int* te = tbl_ent(u.par);
#pragma unroll
        for (int h = 0; h < 2; ++h)
#pragma unroll
            for (int i = 0; i < 2; ++i) {
                const int r = R[i] + 128 * h;
                if (gather) v[h * 2 + i] = (unsigned)(te[r] >> 1) * (unsigned)lda + (unsigned)(C[i] * 2);
                else v[h * 2 + i] = (unsigned)(r * lda + C[i] * 2);
            }
    }
};

template <class Epi, class Sched, bool DYN, bool BF32 = false, bool PAIR = false, bool MSKIP = false, bool TBL = false>
__device__ __forceinline__ void gemm_phase(LAS unsigned char* lds, const int K, const Sched& S, const Epi& E) {
    const int tid = threadIdx.x, wid = __builtin_amdgcn_readfirstlane(tid >> 6), lane = tid & 63, wr = wid >> 2, wc = wid & 3, fr = lane & 15, fq = lane >> 4;
    const int nt = K / BK;
    int Rr[2], Cc[2]; unsigned voffB[2];
#pragma unroll
    for (int i = 0; i < 2; ++i) { stage_rc(tid * 16 + i * 8192, Rr[i], Cc[i]); const int Rb = Epi::PERM ? ((Rr[i] & ~31) + perm32(Rr[i] & 31)) : Rr[i]; voffB[i] = (unsigned)(Rb * K + Cc[i]) * 2u; }
    const size_t kstep = (size_t)(BK * 2);
    const size_t hstepB = (size_t)HALF * K * 2;
    const unsigned ldsw = (unsigned)wid * 1024u;
    const int aoff = lds_byte(wr * 64 + fr, fq * 8), boff = lds_byte(wc * 32 + fr, fq * 8);
    const int ldb = S.ldb;
    const size_t kstepW = (size_t)BK * (size_t)ldb;
    unsigned wgo = 0, wlo = 0;
    if (BF32) {
        static_assert(!BF32 || Epi::PERM, "the f32-weight staging assumes the permuted row slots");
        const int kq = 8 * (wid >> 2) + (lane >> 3), ng = 8 * (wid & 3) + (lane & 7);
        wgo = (unsigned)(4 * kq) * (unsigned)ldb + (unsigned)(16 * ng);
        const int c0 = 4 * ng;
        const int rho0 = Epi::PERM ? (16 * ((c0 >> 2) & 1) + 4 * ((c0 & 31) >> 3)) : (c0 & 31);
        wlo = (unsigned)lds_byte((c0 & ~31) + rho0, 4 * kq);
    }
    f32x4 wr0[4], wr1[4];
#define PG8_WISSUE(set, gbase) do { _Pragma("unroll") for (int _i = 0; _i < 4; ++_i) { const char* _p = (const char*)(gbase) + (size_t)_i * ldb; \
        asm volatile("global_load_dwordx4 %0, %1, %2" : "=v"(set[_i]) : "v"(wgo), "s"(_p) : "memory"); } } while (0)
#define PG8_WWAIT(set, n) asm volatile("s_waitcnt vmcnt(" #n ")" : "+v"(set[0]), "+v"(set[1]), "+v"(set[2]), "+v"(set[3]) :: "memory")
#define PG8_WCOMMIT(set, bufoff) do { _Pragma("unroll") for (int _j = 0; _j < 4; ++_j) { u32x2 _w; _w.x = cvt_pk_bf16(set[0][_j], set[1][_j]); _w.y = cvt_pk_bf16(set[2][_j], set[3][_j]); \
        *(LAS u32x2*)(lds + (bufoff) + wlo + 64 * _j) = _w; } } while (0)
#define PG8_SA(b, h) (((b) * 2 + (h)) * HTB)
#define PG8_SB(b, h) ((4 + (b) * 2 + (h)) * HTB)
#define PG8_STAGE2(bufoff, gbase, o0, o1) do { \
        __builtin_amdgcn_global_load_lds((const unsigned*)((const char*)(gbase) + (o0)), (LAS unsigned*)(lds + (bufoff) + ldsw), 16, 0, 0); \
        __builtin_amdgcn_global_load_lds((const unsigned*)((const char*)(gbase) + (o1)), (LAS unsigned*)(lds + (bufoff) + ldsw + 8192), 16, 0, 0); } while (0)
#define PG8_STAGEB(bufoff, gbase) PG8_STAGE2(bufoff, gbase, voffB[0], voffB[1])
#define PG8_STAGEA(bufoff, gbase, v, h) PG8_STAGE2(bufoff, gbase, (v)[(h) * 2], (v)[(h) * 2 + 1])
#define PG8_TREAD(par, h, e0, e1) do { int _tz = threadIdx.x; asm volatile("" : "+v"(_tz)); int _r0, _c0, _r1, _c1; stage_rc(_tz * 16, _r0, _c0); stage_rc(_tz * 16 + 8192, _r1, _c1); \
        const LAS int* _te = S.tbl_ent(par); e0 = _te[_r0 + 128 * (h)]; e1 = _te[_r1 + 128 * (h)]; } while (0)
#define PG8_STAGEA_G(bufoff, gbase, e0, e1) do { int _tz = threadIdx.x; asm volatile("" : "+v"(_tz)); int _r0, _c0, _r1, _c1; stage_rc(_tz * 16, _r0, _c0); stage_rc(_tz * 16 + 8192, _r1, _c1); \
        PG8_STAGE2(bufoff, gbase, (unsigned)((e0) >> 1) * (unsigned)S.lda + (unsigned)(_c0 * 2), (unsigned)((e1) >> 1) * (unsigned)S.lda + (unsigned)(_c1 * 2)); } while (0)
#define PG8_LDA(dst, b, h) do { _Pragma("unroll") for (int m = 0; m < 4; ++m) _Pragma("unroll") for (int k = 0; k < 2; ++k) dst[m][k] = *(const LAS bf16x8*)(lds + PG8_SA(b, h) + aoff + m * 2048 + k * 1024); } while (0)
#define PG8_LDB(dst, b, h) do { _Pragma("unroll") for (int n = 0; n < 2; ++n) _Pragma("unroll") for (int k = 0; k < 2; ++k) dst[n][k] = *(const LAS bf16x8*)(lds + PG8_SB(b, h) + boff + n * 2048 + k * 1024); } while (0)
#define PG8_MMA(ai, bj, At, Bt) do { __builtin_amdgcn_s_setprio(1); _Pragma("unroll") for (int m = 0; m < 4; ++m) _Pragma("unroll") for (int n = 0; n < 2; ++n) _Pragma("unroll") for (int k = 0; k < 2; ++k) \
        acc[ai][bj][m][n] = __builtin_amdgcn_mfma_f32_16x16x32_bf16(Bt[n][k], At[m][k], acc[ai][bj][m][n], 0, 0, 0); __builtin_amdgcn_s_setprio(0); } while (0)
#define PG8_WAIT_V(n) asm volatile("s_waitcnt vmcnt(" #n ")" ::: "memory")
#define PG8_WAIT_L(n) asm volatile("s_waitcnt lgkmcnt(" #n ")" ::: "memory")
#define PG8_BAR __builtin_amdgcn_s_barrier()
#define PG8_SCHED __builtin_amdgcn_sched_barrier(0)
    Unit cur, nxt; int ui = 0;
    if (!S.next(0, cur)) return;
    f32x4 acc[2][2][4][2];
#pragma unroll
    for (int a = 0; a < 2; ++a)
#pragma unroll
        for (int b = 0; b < 2; ++b)
#pragma unroll
            for (int m = 0; m < 4; ++m)
#pragma unroll
                for (int n = 0; n < 2; ++n) acc[a][b][m][n] = (f32x4){0.f, 0.f, 0.f, 0.f};
    bf16x8 At[4][2], B0[2][2], B1[2][2];
    constexpr bool GT = TBL && DYN;
    unsigned vc[4], vn[4];
    int ge0 = 0, ge1 = 0;
    int tb_e = 0, tb_v = 0;
    if constexpr (BF32) { PG8_WISSUE(wr0, cur.B); PG8_WISSUE(wr1, cur.B1); }
    if constexpr (TBL) {
        if (tid < 256) { const int e0 = *S.entry_ptr(cur, tid); S.tbl_ent(cur.par)[tid] = e0; S.tbl_val(cur.par)[tid] = *S.val_ptr(e0); }
        PG8_WAIT_L(0); PG8_BAR;
    }
    if constexpr (!GT) {
        S.aoffs(cur, Rr, Cc, vc);
#pragma unroll
        for (int j = 0; j < 4; ++j) vn[j] = vc[j];
    }
    const char* cA = cur.A; const char* cB = cur.B; const char* cB1 = cur.B1;
    if (!BF32) {
        PG8_STAGEB(PG8_SB(0, 0), cB); PG8_STAGEA(PG8_SA(0, 0), cA, vc, 0); PG8_STAGEB(PG8_SB(0, 1), cB + hstepB); PG8_STAGEA(PG8_SA(0, 1), cA, vc, 1);
        if (wr == 1) PG8_BAR;
        PG8_WAIT_V(4); PG8_BAR;
        PG8_STAGEB(PG8_SB(1, 0), cB + kstep); PG8_STAGEA(PG8_SA(1, 0), cA + kstep, vc, 0); PG8_STAGEB(PG8_SB(1, 1), cB + hstepB + kstep);
        PG8_WAIT_V(6); PG8_BAR;
    } else {
        if constexpr (GT) { PG8_TREAD(cur.par, 0, ge0, ge1); PG8_STAGEA_G(PG8_SA(0, 0), cA, ge0, ge1); PG8_TREAD(cur.par, 1, ge0, ge1); PG8_STAGEA_G(PG8_SA(0, 1), cA, ge0, ge1); }
        else { PG8_STAGEA(PG8_SA(0, 0), cA, vc, 0); PG8_STAGEA(PG8_SA(0, 1), cA, vc, 1); }
        PG8_WWAIT(wr0, 8); PG8_WCOMMIT(wr0, PG8_SB(0, 0)); PG8_WWAIT(wr1, 4); PG8_WCOMMIT(wr1, PG8_SB(0, 1));
        PG8_WISSUE(wr0, cB + kstepW); PG8_WISSUE(wr1, cB1 + kstepW);
        if constexpr (GT) { PG8_TREAD(cur.par, 0, ge0, ge1); PG8_STAGEA_G(PG8_SA(1, 0), cA + kstep, ge0, ge1); } else PG8_STAGEA(PG8_SA(1, 0), cA + kstep, vc, 0);
        PG8_WWAIT(wr0, 6); PG8_WCOMMIT(wr0, PG8_SB(1, 0));
        PG8_WISSUE(wr0, cB + 2 * kstepW);
        if constexpr (GT) PG8_TREAD(cur.par, 1, ge0, ge1);
        if (wr == 1) PG8_BAR;
        PG8_WAIT_V(4); PG8_WAIT_L(0); PG8_BAR;
        PG8_BAR;
    }
    for (;;) {
        const bool has_next = S.next(ui + 1, nxt);
        const bool full = !MSKIP || cur.cnt > 128;
        if constexpr (TBL) { if (has_next && tid < 256) { const int* ep = S.entry_ptr(nxt, tid); asm volatile("global_load_dword %0, %1, off" : "=v"(tb_e) : "v"(ep) : "memory"); } }
        const char* nA = has_next ? nxt.A : cA; const char* nB = has_next ? nxt.B : cB; const char* nB1 = has_next ? nxt.B1 : cB1;
        for (int t = 0; t < nt; t += 2) {
            const bool last = (t == nt - 2);
            const char* a1 = cA + (size_t)(t + 1) * kstep;
            const char* a2 = last ? nA : cA + (size_t)(t + 2) * kstep; const char* b2 = last ? nB : cB + (size_t)(t + 2) * kstep;
            const char* a3 = a2 + kstep; const char* b3 = b2 + kstep;
            const char* w21 = last ? nB1 : cB1 + (size_t)(t + 2) * kstepW;
            const char* w30 = last ? nB + kstepW : cB + (size_t)(t + 3) * kstepW;
            const char* w31 = last ? nB1 + kstepW : cB1 + (size_t)(t + 3) * kstepW;
            const char* w40 = last ? nB + 2 * kstepW : (t + 4 < nt ? cB + (size_t)(t + 4) * kstepW : nB);
            if constexpr (TBL) {
                if (has_next && tid < 256) {
                    if (t == (nt >> 1)) {
                        asm volatile("s_waitcnt vmcnt(10)" : "+v"(tb_e) :: "memory");
                        S.tbl_ent(nxt.par)[tid] = tb_e;
                        const float* vp = S.val_ptr(tb_e); asm volatile("global_load_dword %0, %1, off" : "=v"(tb_v) : "v"(vp) : "memory");
                    }
                    if (last) {
                        asm volatile("s_waitcnt vmcnt(10)" : "+v"(tb_v) :: "memory");
                        S.tbl_ent(nxt.par)[256 + tid] = tb_v;
                    }
                }
            }
            const int npar = (last && has_next) ? nxt.par : cur.par;
            if constexpr (GT) { PG8_STAGEA_G(PG8_SA(1, 1), a1, ge0, ge1); PG8_SCHED; }
            PG8_LDB(B0, 0, 0); PG8_SCHED; PG8_LDA(At, 0, 0);
            if constexpr (!GT) PG8_STAGEA(PG8_SA(1, 1), a1, vc, 1);
            PG8_WAIT_L(8); PG8_BAR; PG8_WAIT_L(0); PG8_MMA(0, 0, At, B0); PG8_BAR; PG8_SCHED;
            if (DYN && !GT) { if (last && has_next) {
                int tz = threadIdx.x; asm volatile("" : "+v"(tz)); int R2[2], C2[2];
#pragma unroll
                for (int i = 0; i < 2; ++i) stage_rc(tz * 16 + i * 8192, R2[i], C2[i]);
                S.aoffs(nxt, R2, C2, vn); } }
            PG8_LDB(B1, 0, 1);
            if (BF32) { PG8_WWAIT(wr1, 8); PG8_WCOMMIT(wr1, PG8_SB(1, 1)); PG8_WISSUE(wr1, w21); } else PG8_STAGEB(PG8_SB(0, 0), b2);
            if constexpr (GT) PG8_TREAD(npar, 0, ge0, ge1);
            PG8_BAR; PG8_WAIT_L(0); PG8_MMA(0, 1, At, B1); PG8_BAR;
            if constexpr (GT) { PG8_STAGEA_G(PG8_SA(0, 0), a2, ge0, ge1); PG8_SCHED; }
            if (full) PG8_LDA(At, 0, 1);
            if constexpr (!GT) PG8_STAGEA(PG8_SA(0, 0), a2, vn, 0);
            PG8_BAR; PG8_WAIT_L(0); if (full) PG8_MMA(1, 0, At, B0); PG8_BAR; PG8_SCHED;
            if (BF32) { PG8_WWAIT(wr0, 8); PG8_WCOMMIT(wr0, PG8_SB(0, 0)); PG8_WISSUE(wr0, w30); PG8_WAIT_V(10); } else { PG8_STAGEB(PG8_SB(0, 1), b2 + hstepB); PG8_WAIT_V(6); }
            if constexpr (GT) { PG8_TREAD(npar, 1, ge0, ge1); PG8_WAIT_L(0); }
            PG8_BAR; if (full) PG8_MMA(1, 1, At, B1); PG8_BAR;
            if constexpr (GT) { PG8_STAGEA_G(PG8_SA(0, 1), a2, ge0, ge1); PG8_SCHED; }
            PG8_LDB(B0, 1, 0); PG8_SCHED; PG8_LDA(At, 1, 0);
            if constexpr (!GT) PG8_STAGEA(PG8_SA(0, 1), a2, vn, 1);
            PG8_WAIT_L(8); PG8_BAR; PG8_WAIT_L(0); PG8_MMA(0, 0, At, B0); PG8_BAR; PG8_SCHED;
            PG8_LDB(B1, 1, 1);
            if (BF32) { PG8_WWAIT(wr1, 8); PG8_WCOMMIT(wr1, PG8_SB(0, 1)); PG8_WISSUE(wr1, w31); } else PG8_STAGEB(PG8_SB(1, 0), b3);
            if constexpr (GT) PG8_TREAD(npar, 0, ge0, ge1);
            PG8_BAR; PG8_WAIT_L(0); PG8_MMA(0, 1, At, B1); PG8_BAR;
            if constexpr (GT) { PG8_STAGEA_G(PG8_SA(1, 0), a3, ge0, ge1); PG8_SCHED; }
            if (full) PG8_LDA(At, 1, 1);
            if constexpr (!GT) PG8_STAGEA(PG8_SA(1, 0), a3, vn, 0);
            PG8_BAR; PG8_WAIT_L(0); if (full) PG8_MMA(1, 0, At, B0); PG8_BAR; PG8_SCHED;
            if (BF32) { PG8_WWAIT(wr0, 8); PG8_WCOMMIT(wr0, PG8_SB(1, 0)); PG8_WISSUE(wr0, w40); PG8_WAIT_V(10); } else { PG8_STAGEB(PG8_SB(1, 1), b3 + hstepB); PG8_WAIT_V(6); }
            if constexpr (GT) { PG8_TREAD(npar, 1, ge0, ge1); PG8_WAIT_L(0); }
            PG8_BAR; if (full) PG8_MMA(1, 1, At, B1); PG8_BAR;
        }
        if constexpr (PAIR) {
            if (cur.e == 0) E.first(acc, cur, wr, wc, fr, fq); else E(acc, cur, wr, wc, fr, fq);
        } else E(acc, cur, wr, wc, fr, fq);
        if (!has_next) break;
        if (!(PAIR && cur.e == 0)) {
#pragma unroll
        for (int a = 0; a < 2; ++a)
#pragma unroll
            for (int b = 0; b < 2; ++b)
#pragma unroll
                for (int m = 0; m < 4; ++m)
#pragma unroll
                    for (int n = 0; n < 2; ++n) acc[a][b][m][n] = (f32x4){0.f, 0.f, 0.f, 0.f};
        }
        cur = nxt; cA = nA; cB = nB; cB1 = nB1; ++ui;
        if (DYN && !GT) {
#pragma unroll
            for (int j = 0; j < 4; ++j) vc[j] = vn[j];
        }
    }
    PG8_WAIT_V(0);
    if (BF32) { asm volatile("" :: "v"(wr0[0]), "v"(wr0[1]), "v"(wr0[2]), "v"(wr0[3]), "v"(wr1[0]), "v"(wr1[1]), "v"(wr1[2]), "v"(wr1[3])); }
    if (wr == 0) PG8_BAR;
    PG8_BAR;
#undef PG8_WISSUE
#undef PG8_WCOMMIT
#undef PG8_WWAIT
#undef PG8_SA
#undef PG8_SB
#undef PG8_STAGE2
#undef PG8_STAGEA
#undef PG8_TREAD
#undef PG8_STAGEA_G
#undef PG8_STAGEB
#undef PG8_LDA
#undef PG8_LDB
#undef PG8_MMA
#undef PG8_WAIT_V
#undef PG8_WAIT_L
#undef PG8_BAR
#undef PG8_SCHED
}
}

constexpr int LDS_STAGE = pg8::STAGE_BYTES;
constexpr int LDS_WORK = 144 * 1024;
constexpr int MISC_OFF = LDS_WORK;
constexpr int LDS_BYTES = LDS_WORK + 12288;
constexpr int MOE_ROWTBL_OFF = MISC_OFF + 2048;

struct Args {
    const float* in[28];
    float* out; unsigned char* ws;
    int ph_lo, ph_hi;
};

struct Frame {
    LAS unsigned char* lds;
    const float* in[28]; float* out; unsigned char* ws;
    int tid, lane, wave, G, vb;
};

enum { I_X = 0, I_META, I_NORM_MIX, I_W_IN, I_SSD_CONV_W, I_SSD_CONV_B, I_SSD_DT_BIAS, I_SSD_A_LOG, I_SSD_D, I_SSD_NORM, I_W_SSD_OUT, I_LRU_CONV_W, I_LRU_CONV_B, I_LRU_WA, I_LRU_BA, I_LRU_WX, I_LRU_BX,
       I_LRU_LAMBDA, I_W_LRU_OUT, I_GATE_BIAS, I_W_OUT, I_NORM_FFN, I_W_RG, I_W_RE, I_W_EG, I_W_EU, I_W_ED, I_NORM_FINAL };

__device__ __forceinline__ int seq_row(int b, int t) { return t < NMETA ? T + t : b * SEQ + (t - NMETA); }

__device__ __forceinline__ int rowmap(int kind, int n) {
    switch (kind) {
        case 1: return n < 6144 ? n : (n < 6176 ? n + 8192 : n - 32);
        case 2: case 4: return (n >> 7) * 256 + (n & 127);
        case 3: case 5: return (n >> 7) * 256 + 128 + (n & 127);
        default: return n;
    }
}
__device__ void tconv(const Frame& F, const float* __restrict__ src, int K, int N, bf16_t* __restrict__ dst, int ldd, int kind, int& tilebase) {
    const int nbk = K / 64, nbn = N / 32, nblk = nbk * nbn;
    const int gw = F.vb * 8 + F.wave, nw = F.G * 8;
    int first = (gw - tilebase) % nw; if (first < 0) first += nw;
    const int ng = F.lane & 7, kg = F.lane >> 3;
    for (int t = first; t < nblk; t += nw) {
        const int bk = t % nbk, bn = t / nbk;
        const int n = bn * 32 + 4 * ng, k = bk * 64 + 8 * kg;
        f32x4 v[8];
#pragma unroll
        for (int i = 0; i < 8; ++i) v[i] = *(const f32x4*)(src + (size_t)(k + i) * N + n);
#pragma unroll
        for (int j = 0; j < 4; ++j) {
            u32x4 w; w.x = cvt_pk_bf16(v[0][j], v[1][j]); w.y = cvt_pk_bf16(v[2][j], v[3][j]); w.z = cvt_pk_bf16(v[4][j], v[5][j]); w.w = cvt_pk_bf16(v[6][j], v[7][j]);
            *(u32x4*)(dst + (size_t)rowmap(kind, n + j) * ldd + k) = w;
        }
    }
    tilebase += nblk;
}

__device__ void p0_prologue(const Frame& F) {
    {
        bf16_t* U = (bf16_t*)(F.ws + WS_U);
        const float* g = F.in[I_NORM_MIX];
        for (int row = F.vb * 8 + F.wave; row < TR; row += F.G * 8) {
            const float* src = row < T ? F.in[I_X] + (size_t)row * D : F.in[I_META] + (size_t)(row - T) * D;
            f32x4 v[8]; float ss = 0.f;
#pragma unroll
            for (int i = 0; i < 8; ++i) { v[i] = *(const f32x4*)(src + i * 256 + F.lane * 4); ss += v[i][0] * v[i][0] + v[i][1] * v[i][1] + v[i][2] * v[i][2] + v[i][3] * v[i][3]; }
            ss = wave_sum(ss);
            const float rstd = rsqrtf(ss * (1.0f / D) + EPS);
#pragma unroll
            for (int i = 0; i < 8; ++i) {
                const f32x4 gg = *(const f32x4*)(g + i * 256 + F.lane * 4);
                u32x2 w; w.x = cvt_pk_bf16(v[i][0] * rstd * gg[0], v[i][1] * rstd * gg[1]); w.y = cvt_pk_bf16(v[i][2] * rstd * gg[2], v[i][3] * rstd * gg[3]);
                *(u32x2*)(U + (size_t)row * D + i * 256 + F.lane * 4) = w;
            }
        }
    }
    {
        bf16_t* WH = (bf16_t*)(F.ws + WS_WRH); bf16_t* WL = (bf16_t*)(F.ws + WS_WRL);
        const float* wrg = F.in[I_W_RG]; const float* wre = F.in[I_W_RE];
        for (int i = F.vb * NTHREADS + F.tid; i < 96 * 2048; i += F.G * NTHREADS) {
            const int n = i >> 11, k = i & 2047;
            const float v = n < 8 ? wrg[(size_t)k * 8 + n] : (n < 72 ? wre[(size_t)k * 64 + (n - 8)] : 0.f);
            const unsigned short hi = f2bf(v);
            WH[i] = hi; WL[i] = f2bf(v - bf2f(hi));
        }
    }
    int tb = 0;
    tconv(F, F.in[I_W_IN], 2048, 14368, (bf16_t*)(F.ws + WS_WIN), 2048, 1, tb);
    tconv(F, F.in[I_W_SSD_OUT], 2048, 2048, (bf16_t*)(F.ws + WS_WSO), 2048, 0, tb);
    tconv(F, F.in[I_W_LRU_OUT], 2048, 2048, (bf16_t*)(F.ws + WS_WLO), 2048, 0, tb);
    tconv(F, F.in[I_W_OUT], 2048, 2048, (bf16_t*)(F.ws + WS_WOUT), 2048, 0, tb);
    for (int h = 0; h < 8; ++h) {
        tconv(F, F.in[I_LRU_WA] + (size_t)h * 65536, 256, 256, (bf16_t*)(F.ws + WS_WLRU) + (size_t)h * 512 * 256, 256, 4, tb);
        tconv(F, F.in[I_LRU_WX] + (size_t)h * 65536, 256, 256, (bf16_t*)(F.ws + WS_WLRU) + (size_t)h * 512 * 256, 256, 5, tb);
    }
}

struct EpiProj {
    static constexpr bool PERM = true;
    bf16_t* P; const float* gate_bias;
    __device__ __forceinline__ void operator()(const f32x4 (&acc)[2][2][4][2], const pg8::Unit& u, int wr, int wc, int fr, int fq) const {
        const int row0 = u.pm * 256 + wr * 64 + fr, col0 = u.pn * 256 + wc * 32 + 8 * fq;
        const int kind = u.pn < 8 ? 0 : (u.pn < 32 ? 1 : (u.pn < 40 ? 2 : 3));
        f32x4 gb[4] = {(f32x4){0.f, 0.f, 0.f, 0.f}, (f32x4){0.f, 0.f, 0.f, 0.f}, (f32x4){0.f, 0.f, 0.f, 0.f}, (f32x4){0.f, 0.f, 0.f, 0.f}};
        if (kind == 3) {
            const float* bp = gate_bias + (col0 - OGL);
            asm volatile("global_load_dwordx4 %0, %1, off" : "=v"(gb[0]) : "v"(bp) : "memory");
            asm volatile("global_load_dwordx4 %0, %1, off offset:16" : "=v"(gb[1]) : "v"(bp) : "memory");
            asm volatile("global_load_dwordx4 %0, %1, off offset:512" : "=v"(gb[2]) : "v"(bp) : "memory");
            asm volatile("global_load_dwordx4 %0, %1, off offset:528" : "=v"(gb[3]) : "v"(bp) : "memory");
            asm volatile("s_waitcnt vmcnt(0)" : "+v"(gb[0]), "+v"(gb[1]), "+v"(gb[2]), "+v"(gb[3]) :: "memory");
        }
#pragma unroll
        for (int bj = 0; bj < 2; ++bj) {
            const f32x4 b0 = gb[bj * 2], b1 = gb[bj * 2 + 1];
#pragma unroll
            for (int ai = 0; ai < 2; ++ai)
#pragma unroll
                for (int m = 0; m < 4; ++m) {
                    f32x4 v0 = acc[ai][bj][m][0], v1 = acc[ai][bj][m][1];
                    if (kind == 0) {
#pragma unroll
                        for (int j = 0; j < 4; ++j) { v0[j] = siluf_(v0[j]); v1[j] = siluf_(v1[j]); }
                    } else if (kind == 2) {
#pragma unroll
                        for (int j = 0; j < 4; ++j) { v0[j] = gelu_tanh_(v0[j]); v1[j] = gelu_tanh_(v1[j]); }
                    } else if (kind == 3) {
#pragma unroll
                        for (int j = 0; j < 4; ++j) { v0[j] = sigmoidf_(v0[j] + b0[j]); v1[j] = sigmoidf_(v1[j] + b1[j]); }
                    }
                    u32x4 w; w.x = cvt_pk_bf16(v0[0], v0[1]); w.y = cvt_pk_bf16(v0[2], v0[3]); w.z = cvt_pk_bf16(v1[0], v1[1]); w.w = cvt_pk_bf16(v1[2], v1[3]);
                    *(u32x4*)(P + (size_t)(row0 + ai * 128 + m * 16) * NP + col0 + bj * 128) = w;
                }
        }
    }
};

struct EpiLru {
    static constexpr bool PERM = true;
    const bf16_t* XR; bf16_t* LOGA; bf16_t* LU; const float* ba; const float* bx; const float* lam;
    __device__ __forceinline__ void operator()(const f32x4 (&acc)[2][2][4][2], const pg8::Unit& u, int wr, int wc, int fr, int fq) const {
        const int row0 = u.pm * 256 + wr * 64 + fr;
#pragma unroll
        for (int n = 0; n < 2; ++n) {
            const int ch0 = (u.pn >> 1) * 256 + (u.pn & 1) * 128 + wc * 32 + 8 * fq + 4 * n;
            const f32x4 bav = *(const f32x4*)(ba + ch0), bxv = *(const f32x4*)(bx + ch0), lmv = *(const f32x4*)(lam + ch0);
            f32x4 spl;
#pragma unroll
            for (int j = 0; j < 4; ++j) spl[j] = -8.0f * softplusf_(-lmv[j]);
            u32x2 xq[8];
#pragma unroll
            for (int q = 0; q < 8; ++q) { const bf16_t* xp = XR + (size_t)(row0 + (q >> 2) * 128 + (q & 3) * 16) * D + ch0; asm volatile("global_load_dwordx2 %0, %1, off" : "=v"(xq[q]) : "v"(xp) : "memory"); }
            asm volatile("s_waitcnt vmcnt(0)" : "+v"(xq[0]), "+v"(xq[1]), "+v"(xq[2]), "+v"(xq[3]), "+v"(xq[4]), "+v"(xq[5]), "+v"(xq[6]), "+v"(xq[7]) :: "memory");
#pragma unroll
            for (int ai = 0; ai < 2; ++ai)
#pragma unroll
                for (int m = 0; m < 4; ++m) {
                    const size_t off = (size_t)(row0 + ai * 128 + m * 16) * D + ch0;
                    const u32x2 xw = xq[ai * 4 + m];
                    const float xr[4] = {bflo(xw.x), bfhi(xw.x), bflo(xw.y), bfhi(xw.y)};
                    float la[4], uu[4];
#pragma unroll
                    for (int j = 0; j < 4; ++j) {
                        const float pr = acc[ai][0][m][n][j] + bav[j], pi = acc[ai][1][m][n][j] + bxv[j];
                        const float l = spl[j] * sigmoidf_(pr);
                        la[j] = l;
                        uu[j] = __builtin_amdgcn_sqrtf(fmaxf(1.0f - __expf(2.0f * l), 0.0f)) * sigmoidf_(pi) * xr[j];
                    }
                    u32x2 w; w.x = cvt_pk_bf16(la[0], la[1]); w.y = cvt_pk_bf16(la[2], la[3]);
                    *(u32x2*)(LOGA + off) = w;
                    w.x = cvt_pk_bf16(uu[0], uu[1]); w.y = cvt_pk_bf16(uu[2], uu[3]);
                    *(u32x2*)(LU + off) = w;
                }
        }
    }
};

struct EpiMixPair {
    static constexpr bool PERM = true;
    const bf16_t* P; bf16_t* MIX;
    __device__ __forceinline__ void first(f32x4 (&acc)[2][2][4][2], const pg8::Unit& u, int wr, int wc, int fr, int fq) const {
        const int row0 = u.pm * 256 + wr * 64 + fr, col0 = u.pn * 256 + wc * 32 + 8 * fq;
#pragma unroll
        for (int ai = 0; ai < 2; ++ai) {
            u32x4 ga[8], gb[8];
#pragma unroll
            for (int m = 0; m < 4; ++m) {
                const bf16_t* gp = P + (size_t)(row0 + ai * 128 + m * 16) * NP + OGL + col0;
                asm volatile("global_load_dwordx4 %0, %1, off" : "=v"(ga[m * 2 + 0]) : "v"(gp) : "memory");
                asm volatile("global_load_dwordx4 %0, %1, off offset:256" : "=v"(ga[m * 2 + 1]) : "v"(gp) : "memory");
                asm volatile("global_load_dwordx4 %0, %1, off" : "=v"(gb[m * 2 + 0]) : "v"(gp + D) : "memory");
                asm volatile("global_load_dwordx4 %0, %1, off offset:256" : "=v"(gb[m * 2 + 1]) : "v"(gp + D) : "memory");
            }
            asm volatile("s_waitcnt vmcnt(0)" : "+v"(ga[0]), "+v"(ga[1]), "+v"(ga[2]), "+v"(ga[3]), "+v"(ga[4]), "+v"(ga[5]), "+v"(ga[6]), "+v"(ga[7]),
                         "+v"(gb[0]), "+v"(gb[1]), "+v"(gb[2]), "+v"(gb[3]), "+v"(gb[4]), "+v"(gb[5]), "+v"(gb[6]), "+v"(gb[7]) :: "memory");
#pragma unroll
            for (int m = 0; m < 4; ++m)
#pragma unroll
                for (int bj = 0; bj < 2; ++bj) {
                    const u32x4 a = ga[m * 2 + bj], b = gb[m * 2 + bj];
                    const float r[8] = {bflo(a.x) * __builtin_amdgcn_rcpf(bflo(b.x)), bfhi(a.x) * __builtin_amdgcn_rcpf(bfhi(b.x)), bflo(a.y) * __builtin_amdgcn_rcpf(bflo(b.y)), bfhi(a.y) * __builtin_amdgcn_rcpf(bfhi(b.y)),
                                        bflo(a.z) * __builtin_amdgcn_rcpf(bflo(b.z)), bfhi(a.z) * __builtin_amdgcn_rcpf(bfhi(b.z)), bflo(a.w) * __builtin_amdgcn_rcpf(bflo(b.w)), bfhi(a.w) * __builtin_amdgcn_rcpf(bfhi(b.w))};
#pragma unroll
                    for (int j = 0; j < 4; ++j) { acc[ai][bj][m][0][j] *= r[j]; acc[ai][bj][m][1][j] *= r[4 + j]; }
                }
        }
    }
    __device__ __forceinline__ void operator()(const f32x4 (&acc)[2][2][4][2], const pg8::Unit& u, int wr, int wc, int fr, int fq) const {
        const int row0 = u.pm * 256 + wr * 64 + fr, col0 = u.pn * 256 + wc * 32 + 8 * fq;
#pragma unroll
        for (int ai = 0; ai < 2; ++ai) {
            u32x4 gg[8];
#pragma unroll
            for (int m = 0; m < 4; ++m) {
                const bf16_t* gp = P + (size_t)(row0 + ai * 128 + m * 16) * NP + OGL + D + col0;
                asm volatile("global_load_dwordx4 %0, %1, off" : "=v"(gg[m * 2 + 0]) : "v"(gp) : "memory");
                asm volatile("global_load_dwordx4 %0, %1, off offset:256" : "=v"(gg[m * 2 + 1]) : "v"(gp) : "memory");
            }
            asm volatile("s_waitcnt vmcnt(0)" : "+v"(gg[0]), "+v"(gg[1]), "+v"(gg[2]), "+v"(gg[3]), "+v"(gg[4]), "+v"(gg[5]), "+v"(gg[6]), "+v"(gg[7]) :: "memory");
#pragma unroll
            for (int m = 0; m < 4; ++m)
#pragma unroll
                for (int bj = 0; bj < 2; ++bj) {
                    const int row = row0 + ai * 128 + m * 16, col = col0 + bj * 128;
                    const u32x4 gw = gg[m * 2 + bj];
                    const float g[8] = {bflo(gw.x), bfhi(gw.x), bflo(gw.y), bfhi(gw.y), bflo(gw.z), bfhi(gw.z), bflo(gw.w), bfhi(gw.w)};
                    f32x4 v0 = acc[ai][bj][m][0], v1 = acc[ai][bj][m][1];
#pragma unroll
                    for (int j = 0; j < 4; ++j) { v0[j] *= g[j]; v1[j] *= g[4 + j]; }
                    u32x4 w; w.x = cvt_pk_bf16(v0[0], v0[1]); w.y = cvt_pk_bf16(v0[2], v0[3]); w.z = cvt_pk_bf16(v1[0], v1[1]); w.w = cvt_pk_bf16(v1[2], v1[3]);
                    *(u32x4*)(MIX + (size_t)row * D + col) = w;
                }
        }
    }
};

struct EpiRes {
    static constexpr bool PERM = false;
    const float* X; float* H1;
    __device__ __forceinline__ void operator()(const f32x4 (&acc)[2][2][4][2], const pg8::Unit& u, int wr, int wc, int fr, int fq) const {
        const int row0 = u.pm * 256 + wr * 64 + fr, col0 = u.pn * 256 + wc * 32 + 4 * fq;
#pragma unroll
        for (int ai = 0; ai < 2; ++ai) {
            f32x4 x[16];
#pragma unroll
            for (int m = 0; m < 4; ++m) {
                const float* xp = X + (size_t)(row0 + ai * 128 + m * 16) * D + col0;
                asm volatile("global_load_dwordx4 %0, %1, off" : "=v"(x[m * 4 + 0]) : "v"(xp) : "memory");
                asm volatile("global_load_dwordx4 %0, %1, off offset:64" : "=v"(x[m * 4 + 1]) : "v"(xp) : "memory");
                asm volatile("global_load_dwordx4 %0, %1, off offset:512" : "=v"(x[m * 4 + 2]) : "v"(xp) : "memory");
                asm volatile("global_load_dwordx4 %0, %1, off offset:576" : "=v"(x[m * 4 + 3]) : "v"(xp) : "memory");
            }
            asm volatile("s_waitcnt vmcnt(0)" : "+v"(x[0]), "+v"(x[1]), "+v"(x[2]), "+v"(x[3]), "+v"(x[4]), "+v"(x[5]), "+v"(x[6]), "+v"(x[7]),
                         "+v"(x[8]), "+v"(x[9]), "+v"(x[10]), "+v"(x[11]), "+v"(x[12]), "+v"(x[13]), "+v"(x[14]), "+v"(x[15]) :: "memory");
#pragma unroll
            for (int m = 0; m < 4; ++m)
#pragma unroll
                for (int bj = 0; bj < 2; ++bj)
#pragma unroll
                    for (int n = 0; n < 2; ++n) {
                        const size_t off = (size_t)(row0 + ai * 128 + m * 16) * D + col0 + bj * 128 + n * 16;
                        *(f32x4*)(H1 + off) = x[m * 4 + bj * 2 + n] + acc[ai][bj][m][n];
                    }
        }
    }
};

struct EpiMoe1 {
    static constexpr bool PERM = true;
    bf16_t* H; LAS const unsigned char* rowtbl;
    __device__ __forceinline__ void operator()(const f32x4 (&acc)[2][2][4][2], const pg8::Unit& u, int wr, int wc, int fr, int fq) const {
        const int lrow0 = wr * 64 + fr, row0 = u.pm * 256 + lrow0, col0 = u.pn * 128 + wc * 32 + 8 * fq;
        const LAS float* tv = (const LAS float*)(rowtbl + u.par * 2048 + 1024);
#pragma unroll
        for (int ai = 0; ai < 2; ++ai)
#pragma unroll
            for (int m = 0; m < 4; ++m) {
                const float rs = tv[lrow0 + ai * 128 + m * 16];
                float h[8];
#pragma unroll
                for (int j = 0; j < 8; ++j) h[j] = siluf_(rs * acc[ai][0][m][j >> 2][j & 3]) * (rs * acc[ai][1][m][j >> 2][j & 3]);
                u32x4 w; w.x = cvt_pk_bf16(h[0], h[1]); w.y = cvt_pk_bf16(h[2], h[3]); w.z = cvt_pk_bf16(h[4], h[5]); w.w = cvt_pk_bf16(h[6], h[7]);
                *(u32x4*)(H + (size_t)(row0 + ai * 128 + m * 16) * FF + col0) = w;
            }
    }
};

struct EpiMoe2 {
    static constexpr bool PERM = true;
    bf16_t* Y; LAS const unsigned char* rowtbl;
    __device__ __forceinline__ void operator()(const f32x4 (&acc)[2][2][4][2], const pg8::Unit& u, int wr, int wc, int fr, int fq) const {
        const int lrow0 = wr * 64 + fr, col0 = u.pn * 256 + wc * 32 + 8 * fq;
        const LAS int* te = (const LAS int*)(rowtbl + u.par * 2048);
        const LAS float* tv = (const LAS float*)(rowtbl + u.par * 2048 + 1024);
#pragma unroll
        for (int ai = 0; ai < 2; ++ai)
#pragma unroll
            for (int m = 0; m < 4; ++m) {
                const int lr = lrow0 + ai * 128 + m * 16;
                if (lr < u.cnt) {
                    const int ent = te[lr]; const float g = tv[lr];
#pragma unroll
                    for (int bj = 0; bj < 2; ++bj) {
                        const f32x4 v0 = acc[ai][bj][m][0] * g, v1 = acc[ai][bj][m][1] * g;
                        u32x4 w; w.x = cvt_pk_bf16(v0[0], v0[1]); w.y = cvt_pk_bf16(v0[2], v0[3]); w.z = cvt_pk_bf16(v1[0], v1[1]); w.w = cvt_pk_bf16(v1[2], v1[3]);
                        *(u32x4*)(Y + (size_t)ent * D + col0 + bj * 128) = w;
                    }
                }
            }
    }
};

__device__ void p1_thin(const Frame& F) {
    const bf16_t* U = (const bf16_t*)(F.ws + WS_U);
    const bf16_t* W = (const bf16_t*)(F.ws + WS_WIN);
    bf16_t* P = (bf16_t*)(F.ws + WS_PROJ);
    float* DT = (float*)(F.ws + WS_DT);
    const int NDT = 513, NMT = 192, NIT = NDT + NMT;
    LAS float* red = (LAS float*)F.lds;
    const int r = F.lane & 31, h = F.lane >> 5, quad = F.wave >> 2, kq = F.wave & 3;
    for (int base = F.vb * 2; base < NIT; base += F.G * 2) {
        const int it = base + quad;
        const bool act = it < NIT;
        int row0 = 0, bcol0 = NP, nvalid = 0;
        if (act) {
            if (it < NDT) { row0 = it * 32; bcol0 = NP; nvalid = (TR - row0) < 32 ? (TR - row0) : 32; }
            else { row0 = T; bcol0 = OXBC + (it - NDT) * 32; nvalid = 16; }
        }
        f32x16 acc;
#pragma unroll
        for (int j = 0; j < 16; ++j) acc[j] = 0.f;
        if (act) {
            const int arow = row0 + (r < nvalid ? r : 0);
            const bf16_t* ap = U + (size_t)arow * D + kq * 512 + 8 * h;
            const bf16_t* bp = W + (size_t)(bcol0 + r) * D + kq * 512 + 8 * h;
#pragma unroll 1
            for (int kb = 0; kb < 512; kb += 128) {
                bf16x8 fa[8], fb[8];
#pragma unroll
                for (int k = 0; k < 8; ++k) { fa[k] = *(const bf16x8*)(ap + kb + k * 16); fb[k] = *(const bf16x8*)(bp + kb + k * 16); }
                __builtin_amdgcn_sched_barrier(0);
#pragma unroll
                for (int k = 0; k < 8; ++k) acc = __builtin_amdgcn_mfma_f32_32x32x16_bf16(fa[k], fb[k], acc, 0, 0, 0);
            }
        }
#pragma unroll
        for (int j = 0; j < 16; ++j) red[((quad * 4 + kq) * 16 + j) * 64 + F.lane] = acc[j];
        __syncthreads();
        if (act && kq == 0) {
#pragma unroll
            for (int j = 0; j < 16; ++j) {
                const float v = (red[((quad * 4 + 0) * 16 + j) * 64 + F.lane] + red[((quad * 4 + 1) * 16 + j) * 64 + F.lane]) + (red[((quad * 4 + 2) * 16 + j) * 64 + F.lane] + red[((quad * 4 + 3) * 16 + j) * 64 + F.lane]);
                const int i = (j & 3) + 8 * (j >> 2) + 4 * h;
                if (i < nvalid) {
                    if (it < NDT) DT[(size_t)(row0 + i) * 32 + r] = v;
                    else P[(size_t)(row0 + i) * NP + bcol0 + r] = f2bf(v);
                }
            }
        }
        __syncthreads();
    }
}

__device__ void p2_conv(const Frame& F) {
    const bf16_t* P = (const bf16_t*)(F.ws + WS_PROJ);
    bf16_t* XR = (bf16_t*)(F.ws + WS_XR);
    bf16_t* XS = (bf16_t*)(F.ws + WS_XBCS);
    const int cgl = F.tid & 255, rsel = F.tid >> 8;
    constexpr int NU_X = 3 * NBATCH * 128, NU = NU_X + 3;
    for (int u = F.vb; u < NU; u += F.G) {
        int cbk, b, t0;
        if (u < NU_X) { cbk = u % 3; const int q = u / 3; b = q >> 7; t0 = NMETA + ((q & 127) * 2 + rsel) * 8; }
        else { cbk = u - NU_X; b = 0; t0 = rsel * 8; }
        const int cgx = cbk * 256 + cgl;
        const bool isx = cgx < 512;
        const int c0 = isx ? cgx * 8 : (cgx - 512) * 8;
        const float* cw = isx ? F.in[I_SSD_CONV_W] : F.in[I_LRU_CONV_W];
        const float* cb = isx ? F.in[I_SSD_CONV_B] : F.in[I_LRU_CONV_B];
        const int cwld = isx ? 4096 : D;
        const int pcol = (isx ? OXBC : OLX) + c0;
        u32x4 raw[11];
        if (u < NU_X) {
#pragma unroll
            for (int m = 0; m < 11; ++m) raw[m] = *(const u32x4*)(P + (size_t)seq_row(b, t0 - 3 + m) * NP + pcol);
        } else {
#pragma unroll
            for (int m = 0; m < 11; ++m) { const int t = t0 - 3 + m; const u32x4 v = *(const u32x4*)(P + (size_t)seq_row(b, t < 0 ? 0 : t) * NP + pcol); raw[m] = t >= 0 ? v : (u32x4){0u, 0u, 0u, 0u}; }
        }
        u32x2 outw[8][2];
#pragma unroll
        for (int hh = 0; hh < 2; ++hh) {
            const f32x4 b0 = *(const f32x4*)(cb + c0 + 4 * hh);
            f32x4 wg[4];
#pragma unroll
            for (int k = 0; k < 4; ++k) wg[k] = *(const f32x4*)(cw + k * cwld + c0 + 4 * hh);
            f32x4 o[8];
#pragma unroll
            for (int i = 0; i < 8; ++i) o[i] = b0;
#pragma unroll
            for (int m = 0; m < 11; ++m) {
                const unsigned d0 = hh ? raw[m].z : raw[m].x, d1 = hh ? raw[m].w : raw[m].y;
                const f32x4 x = (f32x4){bflo(d0), bfhi(d0), bflo(d1), bfhi(d1)};
#pragma unroll
                for (int k = 0; k < 4; ++k) { const int i = m - k; if (i >= 0 && i < 8) o[i] += wg[k] * x; }
            }
#pragma unroll
            for (int i = 0; i < 8; ++i) {
                f32x4 v = o[i];
                if (isx) { v[0] = siluf_(v[0]); v[1] = siluf_(v[1]); v[2] = siluf_(v[2]); v[3] = siluf_(v[3]); }
                outw[i][hh].x = cvt_pk_bf16(v[0], v[1]); outw[i][hh].y = cvt_pk_bf16(v[2], v[3]);
            }
        }
#pragma unroll
        for (int i = 0; i < 8; ++i) {
            const size_t row = (size_t)seq_row(b, t0 + i);
            u32x4 w; w.x = outw[i][0].x; w.y = outw[i][0].y; w.z = outw[i][1].x; w.w = outw[i][1].y;
            if (isx) *(u32x4*)(XS + row * 4096 + c0) = w; else *(u32x4*)(XR + row * D + c0) = w;
        }
    }
}

__device__ __forceinline__ float ssd_dtload(const float* DT, int b, int head, int ci, int lane) {
    const int t = ci * 64 - 48 + lane;
    return t >= 0 ? DT[(size_t)seq_row(b, t) * 32 + head] : 0.f;
}
__device__ __forceinline__ void ssd_scal(float dtraw, int ci, float dtb, float a_neg, LAS float* scb, int lane) {
    const int t = ci * 64 - 48 + lane;
    float dtv = 0.f;
    if (t >= 0) dtv = softplusf_(dtraw + dtb);
    float cs = dtv * a_neg;
#pragma unroll
    for (int o = 1; o < 64; o <<= 1) { const float v = __shfl_up(cs, o); if (lane >= o) cs += v; }
    const float tot = __shfl(cs, 63);
    scb[lane] = cs; scb[64 + lane] = dtv; scb[128 + lane] = dtv * __expf(tot - cs);
}
__device__ __forceinline__ void ssd_writeout(const LAS unsigned char* yb, const u32x4 zw, bf16_t* dst) {
    const f32x4 y0 = *(const LAS f32x4*)yb, y1 = *(const LAS f32x4*)(yb + 16);
    u32x4 w; w.x = cvt_pk_bf16(y0[0] * bflo(zw.x), y0[1] * bfhi(zw.x)); w.y = cvt_pk_bf16(y0[2] * bflo(zw.y), y0[3] * bfhi(zw.y));
    w.z = cvt_pk_bf16(y1[0] * bflo(zw.z), y1[1] * bfhi(zw.z)); w.w = cvt_pk_bf16(y1[2] * bflo(zw.w), y1[3] * bfhi(zw.w));
    *(u32x4*)dst = w;
}
constexpr int W2_BLOCKS = NEXP * (D / 32) * (FF / 64);
__device__ __forceinline__ void w2_issue(const float* __restrict__ w2, int blk, int lane, f32x4 (&v)[8]) {
    const int e = blk >> 10, bn = (blk >> 4) & 63, bk = blk & 15, ng = lane & 7, kg = lane >> 3;
    const float* src = w2 + (size_t)e * FF * D + (size_t)(bk * 64 + 8 * kg) * D + bn * 32 + 4 * ng;
#pragma unroll
    for (int i = 0; i < 8; ++i) v[i] = *(const f32x4*)(src + (size_t)i * D);
}
__device__ __forceinline__ void w2_commit(bf16_t* __restrict__ w2t, int blk, int lane, const f32x4 (&v)[8]) {
    const int e = blk >> 10, bn = (blk >> 4) & 63, bk = blk & 15, ng = lane & 7, kg = lane >> 3;
    bf16_t* dst = w2t + (size_t)e * D * FF + (size_t)(bn * 32 + 4 * ng) * FF + bk * 64 + 8 * kg;
#pragma unroll
    for (int j = 0; j < 4; ++j) {
        u32x4 w; w.x = cvt_pk_bf16(v[0][j], v[1][j]); w.y = cvt_pk_bf16(v[2][j], v[3][j]); w.z = cvt_pk_bf16(v[4][j], v[5][j]); w.w = cvt_pk_bf16(v[6][j], v[7][j]);
        *(u32x4*)(dst + (size_t)j * FF) = w;
    }
}
__device__ void p2_ssd_chunk(const Frame& F) {
    const bf16_t* P = (const bf16_t*)(F.ws + WS_PROJ);
    const float* DT = (const float*)(F.ws + WS_DT);
    bf16_t* Y = (bf16_t*)(F.ws + WS_YSSD);
    const bf16_t* XS = (const bf16_t*)(F.ws + WS_XBCS);
    LAS unsigned char* L = F.lds;
    constexpr int RSN = 272, RSS = 144;
    constexpr int O_CM = 0, O_BM = O_CM + 64 * RSN, O_BMT = O_BM + 64 * RSN, O_XST = O_BMT + 128 * RSS, O_XWT = O_XST + 64 * RSS, O_MM = O_XWT + 64 * RSS,
                  O_ST0 = O_MM + 64 * RSS, O_ST1 = O_ST0 + 64 * RSN, O_SC = O_ST1 + 64 * RSN, O_YB = O_SC + 2 * 192 * 4;
    static_assert(O_YB + 64 * RSN <= LDS_WORK, "ssd lds");
    LAS float* sc = (LAS float*)(L + O_SC);
    const int tid = F.tid, lane = F.lane, wave = F.wave, r = lane & 31, h = lane >> 5;
    const bool cv = tid < 320;
    const int cg = tid >> 3, run = tid & 7, i0 = run * 8;
    const float* W2 = F.in[I_W_ED]; bf16_t* W2T = (bf16_t*)(F.ws + WS_W2);
    f32x4 cb0[8];
    int cstep = 0;
    for (int unit = F.vb; unit < NBATCH * NHEAD; unit += F.G) {
        const int b = unit >> 5, head = unit & 31, grp = head >> 2;
        const float a_neg = -__expf(F.in[I_SSD_A_LOG][head]), dtb = F.in[I_SSD_DT_BIAS][head], dsk = F.in[I_SSD_D][head];
        const int cc = cg < 8 ? head * 64 + cg * 8 : (cg < 24 ? 2048 + grp * 128 + (cg - 8) * 8 : 3072 + grp * 128 + (cg - 24) * 8);
        f32x16 st0, st1;
#pragma unroll
        for (int j = 0; j < 16; ++j) { st0[j] = 0.f; st1[j] = 0.f; }
        for (int i = tid; i < 64 * RSN / 16; i += NTHREADS) *(LAS u32x4*)(L + O_ST0 + i * 16) = (u32x4){0u, 0u, 0u, 0u};
        u32x4 raw[8];
        if (cv) {
#pragma unroll
            for (int i = 0; i < 8; ++i) { const int t = -48 + i0 + i; raw[i] = (u32x4){0u, 0u, 0u, 0u}; if (t >= 0) raw[i] = *(const u32x4*)(XS + (size_t)seq_row(b, t) * 4096 + cc); }
        }
        float dtn = 0.f;
        if (wave == 7) { ssd_scal(ssd_dtload(DT, b, head, 0, lane), 0, dtb, a_neg, sc, lane); dtn = ssd_dtload(DT, b, head, 1, lane); }
        u32x4 zw = (u32x4){0u, 0u, 0u, 0u};
        __syncthreads();
        for (int ci = 0; ci < 33; ++ci) {
            LAS float* scc = sc + (ci & 1) * 192;
            const int stc = (ci & 1) ? O_ST1 : O_ST0, stn = (ci & 1) ? O_ST0 : O_ST1;
            const int wl = tid >> 3, wc8 = (tid & 7) * 8;
            if (cv) {
                if (cg >= 8) {
                    const int n0 = cg < 24 ? (cg - 8) * 8 : (cg - 24) * 8;
                    const int ob = cg < 24 ? O_BM : O_CM;
#pragma unroll
                    for (int i = 0; i < 8; ++i) *(LAS u32x4*)(L + ob + (i0 + i) * RSN + n0 * 2) = raw[i];
                }
                if (cg < 24) {
                    const int n0 = cg < 8 ? cg * 8 : (cg - 8) * 8;
                    const int ob = cg < 8 ? O_XST : O_BMT;
#pragma unroll
                    for (int d = 0; d < 4; ++d) {
                        u32x4 lo, hi;
                        lo.x = (raw[0][d] & 0xffffu) | (raw[1][d] << 16); lo.y = (raw[2][d] & 0xffffu) | (raw[3][d] << 16); lo.z = (raw[4][d] & 0xffffu) | (raw[5][d] << 16); lo.w = (raw[6][d] & 0xffffu) | (raw[7][d] << 16);
                        hi.x = (raw[0][d] >> 16) | (raw[1][d] & 0xffff0000u); hi.y = (raw[2][d] >> 16) | (raw[3][d] & 0xffff0000u); hi.z = (raw[4][d] >> 16) | (raw[5][d] & 0xffff0000u); hi.w = (raw[6][d] >> 16) | (raw[7][d] & 0xffff0000u);
                        *(LAS u32x4*)(L + ob + (n0 + 2 * d) * RSS + i0 * 2) = lo;
                        *(LAS u32x4*)(L + ob + (n0 + 2 * d + 1) * RSS + i0 * 2) = hi;
                    }
                    if (cg < 8) {
                        const f32x4 w0 = *(const LAS f32x4*)(scc + 128 + i0), w1 = *(const LAS f32x4*)(scc + 128 + i0 + 4);
#pragma unroll
                        for (int d = 0; d < 4; ++d) {
                            u32x4 lo, hi;
                            lo.x = cvt_pk_bf16(bflo(raw[0][d]) * w0[0], bflo(raw[1][d]) * w0[1]); lo.y = cvt_pk_bf16(bflo(raw[2][d]) * w0[2], bflo(raw[3][d]) * w0[3]);
                            lo.z = cvt_pk_bf16(bflo(raw[4][d]) * w1[0], bflo(raw[5][d]) * w1[1]); lo.w = cvt_pk_bf16(bflo(raw[6][d]) * w1[2], bflo(raw[7][d]) * w1[3]);
                            hi.x = cvt_pk_bf16(bfhi(raw[0][d]) * w0[0], bfhi(raw[1][d]) * w0[1]); hi.y = cvt_pk_bf16(bfhi(raw[2][d]) * w0[2], bfhi(raw[3][d]) * w0[3]);
                            hi.z = cvt_pk_bf16(bfhi(raw[4][d]) * w1[0], bfhi(raw[5][d]) * w1[1]); hi.w = cvt_pk_bf16(bfhi(raw[6][d]) * w1[2], bfhi(raw[7][d]) * w1[3]);
                            *(LAS u32x4*)(L + O_XWT + (n0 + 2 * d) * RSS + i0 * 2) = lo;
                            *(LAS u32x4*)(L + O_XWT + (n0 + 2 * d + 1) * RSS + i0 * 2) = hi;
                        }
                    }
                }
            }
            if (wave == 7 && ci + 1 < 33) ssd_scal(dtn, ci + 1, dtb, a_neg, sc + ((ci + 1) & 1) * 192, lane);
            if (ci > 1) ssd_writeout(L + O_YB + wl * RSN + wc8 * 4, zw, Y + ((size_t)b * SEQ + (ci - 2) * 64 + wl) * D + head * 64 + wc8);
            if (wave >= 4) {
                if (cstep > 0) { const int ib = ((cstep - 1) * 8 + wave) * F.G + F.vb; if (ib < W2_BLOCKS) w2_commit(W2T, ib, lane, cb0); }
                { const int ib = (cstep * 8 + wave) * F.G + F.vb; if (ib < W2_BLOCKS) w2_issue(W2, ib, lane, cb0); }
            }
            __syncthreads();
            if (cv && ci + 1 < 33) {
#pragma unroll
                for (int i = 0; i < 8; ++i) raw[i] = *(const u32x4*)(XS + (size_t)seq_row(b, (ci + 1) * 64 - 48 + i0 + i) * 4096 + cc);
            }
            if (ci > 0) zw = *(const u32x4*)(P + ((size_t)b * SEQ + (ci - 1) * 64 + wl) * NP + OZ + head * 64 + wc8);
            if (wave == 7 && ci + 2 < 33) dtn = ssd_dtload(DT, b, head, ci + 2, lane);
            if (wave < 4) {
                if (wave < 3) {
                    const int lb = wave > 0 ? 1 : 0, sb = wave == 2 ? 1 : 0;
                    f32x16 acc;
#pragma unroll
                    for (int j = 0; j < 16; ++j) acc[j] = 0.f;
                    const LAS unsigned char* ap = L + O_CM + (lb * 32 + r) * RSN + h * 16;
                    const LAS unsigned char* bp = L + O_BM + (sb * 32 + r) * RSN + h * 16;
#pragma unroll
                    for (int k = 0; k < 8; ++k) acc = __builtin_amdgcn_mfma_f32_32x32x16_bf16(*(const LAS bf16x8*)(ap + k * 32), *(const LAS bf16x8*)(bp + k * 32), acc, 0, 0, 0);
                    const int s = sb * 32 + r; const float acs = scc[s], dts = scc[64 + s];
#pragma unroll
                    for (int g = 0; g < 4; ++g) {
                        const int lbase = lb * 32 + 8 * g + 4 * h;
                        const f32x4 acl = *(const LAS f32x4*)(scc + lbase);
#pragma unroll
                        for (int e = 0; e < 4; ++e) { const int l = lbase + e; const float v = (s <= l) ? acc[g * 4 + e] * __expf(acl[e] - acs) * dts : 0.f;
                            *(LAS unsigned short*)(L + O_MM + l * RSS + s * 2) = f2bf(v); }
                    }
                }
                {
                    const int pb = wave & 1, nb0 = (wave >> 1) * 2;
                    const float dec = __expf(scc[63]);
#pragma unroll
                    for (int j = 0; j < 16; ++j) { st0[j] *= dec; st1[j] *= dec; }
                    const LAS unsigned char* ap = L + O_XWT + (pb * 32 + r) * RSS + h * 16;
                    const LAS unsigned char* bp0 = L + O_BMT + (nb0 * 32 + r) * RSS + h * 16;
                    const LAS unsigned char* bp1 = bp0 + 32 * RSS;
#pragma unroll
                    for (int k = 0; k < 4; ++k) {
                        const bf16x8 a = *(const LAS bf16x8*)(ap + k * 32);
                        st0 = __builtin_amdgcn_mfma_f32_32x32x16_bf16(a, *(const LAS bf16x8*)(bp0 + k * 32), st0, 0, 0, 0);
                        st1 = __builtin_amdgcn_mfma_f32_32x32x16_bf16(a, *(const LAS bf16x8*)(bp1 + k * 32), st1, 0, 0, 0);
                    }
#pragma unroll
                    for (int g = 0; g < 4; ++g)
#pragma unroll
                        for (int e = 0; e < 4; ++e) {
                            const int p = pb * 32 + 8 * g + 4 * h + e;
                            *(LAS unsigned short*)(L + stn + p * RSN + (nb0 * 32 + r) * 2) = f2bf(st0[g * 4 + e]);
                            *(LAS unsigned short*)(L + stn + p * RSN + (nb0 * 32 + 32 + r) * 2) = f2bf(st1[g * 4 + e]);
                        }
                }
            } else {
                const int q = wave - 4, lb = q >> 1, pb = q & 1;
#pragma unroll
                for (int j = 0; j < 16; ++j) st0[j] = 0.f;
                const LAS unsigned char* ap = L + O_CM + (lb * 32 + r) * RSN + h * 16;
                const LAS unsigned char* bp = L + stc + (pb * 32 + r) * RSN + h * 16;
#pragma unroll
                for (int k = 0; k < 8; ++k) st0 = __builtin_amdgcn_mfma_f32_32x32x16_bf16(*(const LAS bf16x8*)(ap + k * 32), *(const LAS bf16x8*)(bp + k * 32), st0, 0, 0, 0);
#pragma unroll
                for (int g = 0; g < 4; ++g) {
                    const f32x4 acl = *(const LAS f32x4*)(scc + lb * 32 + 8 * g + 4 * h);
#pragma unroll
                    for (int e = 0; e < 4; ++e) st0[g * 4 + e] *= __expf(acl[e]);
                }
            }
            __syncthreads();
            if (wave < 4) {
                if (cstep > 0) { const int ib = ((cstep - 1) * 8 + wave) * F.G + F.vb; if (ib < W2_BLOCKS) w2_commit(W2T, ib, lane, cb0); }
                { const int ib = (cstep * 8 + wave) * F.G + F.vb; if (ib < W2_BLOCKS) w2_issue(W2, ib, lane, cb0); }
            }
            ++cstep;
            if (wave >= 4) {
                const int q = wave - 4, lb = q >> 1, pb = q & 1;
                const LAS unsigned char* ap = L + O_MM + (lb * 32 + r) * RSS + h * 16;
                const LAS unsigned char* bp = L + O_XST + (pb * 32 + r) * RSS + h * 16;
#pragma unroll
                for (int k = 0; k < 4; ++k) if (k < 2 * (lb + 1)) st0 = __builtin_amdgcn_mfma_f32_32x32x16_bf16(*(const LAS bf16x8*)(ap + k * 32), *(const LAS bf16x8*)(bp + k * 32), st0, 0, 0, 0);
                if (ci > 0) {
                    const int p = pb * 32 + r;
#pragma unroll
                    for (int g = 0; g < 4; ++g)
#pragma unroll
                        for (int e = 0; e < 4; ++e) {
                            const int l = lb * 32 + 8 * g + 4 * h + e;
                            const float xs = bf2f(*(const LAS unsigned short*)(L + O_XST + p * RSS + l * 2));
                            *(LAS float*)(L + O_YB + l * RSN + p * 4) = st0[g * 4 + e] + dsk * xs;
                        }
                }
            }
            __syncthreads();
        }
        {
            const int wl = tid >> 3, wc8 = (tid & 7) * 8;
            ssd_writeout(L + O_YB + wl * RSN + wc8 * 4, zw, Y + ((size_t)b * SEQ + 31 * 64 + wl) * D + head * 64 + wc8);
            __syncthreads();
        }
    }
    {
        if (cstep > 0) { const int ib = ((cstep - 1) * 8 + wave) * F.G + F.vb; if (ib < W2_BLOCKS) w2_commit(W2T, ib, lane, cb0); }
        for (int st = cstep; (st * 8 + wave) * F.G + F.vb < W2_BLOCKS; ++st) { const int ib = (st * 8 + wave) * F.G + F.vb; w2_issue(W2, ib, lane, cb0); w2_commit(W2T, ib, lane, cb0); }
    }
}

__device__ void p3_lru_meta(const Frame& F) {
    const bf16_t* XR = (const bf16_t*)(F.ws + WS_XR);
    const bf16_t* W = (const bf16_t*)(F.ws + WS_WLRU);
    bf16_t* LOGA = (bf16_t*)(F.ws + WS_LOGA); bf16_t* LU = (bf16_t*)(F.ws + WS_LU);
    const float* ba = F.in[I_LRU_BA]; const float* bx = F.in[I_LRU_BX]; const float* lam = F.in[I_LRU_LAMBDA];
    const int r = F.lane & 31, h = F.lane >> 5;
    for (int it = F.vb * 8 + F.wave; it < 64; it += F.G * 8) {
        const int head = it >> 3, c32 = it & 7;
        const bf16_t* ap = XR + (size_t)(T + (r < NMETA ? r : 0)) * D + head * 256 + 8 * h;
        const bf16_t* bpr = W + ((size_t)head * 512 + (c32 >> 2) * 256 + (c32 & 3) * 32 + r) * 256 + 8 * h;
        const bf16_t* bpi = bpr + 128 * 256;
        f32x16 ar, ai;
#pragma unroll
        for (int j = 0; j < 16; ++j) { ar[j] = 0.f; ai[j] = 0.f; }
#pragma unroll
        for (int k0 = 0; k0 < 256; k0 += 16) {
            const bf16x8 a = *(const bf16x8*)(ap + k0);
            ar = __builtin_amdgcn_mfma_f32_32x32x16_bf16(a, *(const bf16x8*)(bpr + k0), ar, 0, 0, 0);
            ai = __builtin_amdgcn_mfma_f32_32x32x16_bf16(a, *(const bf16x8*)(bpi + k0), ai, 0, 0, 0);
        }
        const int ch = head * 256 + c32 * 32 + r;
        const float bav = ba[ch], bxv = bx[ch], spl = -8.0f * softplusf_(-lam[ch]);
#pragma unroll
        for (int j = 0; j < 8; ++j) {
            const int row = (j & 3) + 8 * (j >> 2) + 4 * h;
            const size_t off = (size_t)(T + row) * D + ch;
            const float l = spl * sigmoidf_(ar[j] + bav);
            const float u = sqrtf(fmaxf(1.0f - __expf(2.0f * l), 0.0f)) * sigmoidf_(ai[j] + bxv) * bf2f(XR[off]);
            LOGA[off] = f2bf(l); LU[off] = f2bf(u);
        }
    }
}

__device__ void p3_ssd_norm(const Frame& F) {
    const bf16_t* Y = (const bf16_t*)(F.ws + WS_YSSD);
    bf16_t* YN = (bf16_t*)(F.ws + WS_YSSDN);
    const float* nw = F.in[I_SSD_NORM];
    const int half = F.lane >> 5, l32 = F.lane & 31;
    for (int it0 = (F.vb * 8 + F.wave) * 16; it0 < T * NGRP; it0 += F.G * 8 * 16) {
        u32x4 w[8]; float ss[8];
#pragma unroll
        for (int q = 0; q < 8; ++q) { const int it = it0 + q * 2 + half; w[q] = *(const u32x4*)(Y + (size_t)(it >> 3) * D + (it & 7) * 256 + l32 * 8); }
#pragma unroll
        for (int q = 0; q < 8; ++q) {
            const float v[8] = {bflo(w[q].x), bfhi(w[q].x), bflo(w[q].y), bfhi(w[q].y), bflo(w[q].z), bfhi(w[q].z), bflo(w[q].w), bfhi(w[q].w)};
            float a = 0.f;
#pragma unroll
            for (int j = 0; j < 8; ++j) a += v[j] * v[j];
            ss[q] = a;
        }
#pragma unroll
        for (int o = 16; o > 0; o >>= 1) {
#pragma unroll
            for (int q = 0; q < 8; ++q) ss[q] += __shfl_xor(ss[q], o);
        }
#pragma unroll
        for (int q = 0; q < 8; ++q) {
            const int it = it0 + q * 2 + half, g = it & 7;
            const float rstd = rsqrtf(ss[q] * (1.0f / 256.0f) + EPS);
            const f32x4 g0 = *(const f32x4*)(nw + g * 256 + l32 * 8), g1 = *(const f32x4*)(nw + g * 256 + l32 * 8 + 4);
            u32x4 o;
            o.x = cvt_pk_bf16(bflo(w[q].x) * rstd * g0[0], bfhi(w[q].x) * rstd * g0[1]); o.y = cvt_pk_bf16(bflo(w[q].y) * rstd * g0[2], bfhi(w[q].y) * rstd * g0[3]);
            o.z = cvt_pk_bf16(bflo(w[q].z) * rstd * g1[0], bfhi(w[q].z) * rstd * g1[1]); o.w = cvt_pk_bf16(bflo(w[q].w) * rstd * g1[2], bfhi(w[q].w) * rstd * g1[3]);
            *(u32x4*)(YN + (size_t)(it >> 3) * D + g * 256 + l32 * 8) = o;
        }
    }
}

__device__ void p4_lru_scan(const Frame& F) {
    const bf16_t* LA = (const bf16_t*)(F.ws + WS_LOGA);
    const bf16_t* LU = (const bf16_t*)(F.ws + WS_LU);
    const bf16_t* P = (const bf16_t*)(F.ws + WS_PROJ);
    bf16_t* YL = (bf16_t*)(F.ws + WS_YLRU);
    LAS float* sP = (LAS float*)F.lds;
    LAS float* sH = sP + 4096;
    const int cgp = F.tid & 7, seg = F.tid >> 3;
    const int t_lo = seg == 0 ? 0 : NMETA + 32 * seg, t_hi = NMETA + 32 + 32 * seg;
    for (int unit = F.vb; unit < NBATCH * 32; unit += F.G) {
        const int b = unit >> 5, ch0 = (unit & 31) * 64 + cgp * 8;
        float Hh[8], Pp[8];
#pragma unroll
        for (int j = 0; j < 8; ++j) { Hh[j] = 0.f; Pp[j] = 0.f; }
#pragma unroll 4
        for (int t = t_lo; t < t_hi; ++t) {
            const size_t off = (size_t)seq_row(b, t) * D + ch0;
            const u32x4 aw = *(const u32x4*)(LA + off), uw = *(const u32x4*)(LU + off);
            const float la[8] = {bflo(aw.x), bfhi(aw.x), bflo(aw.y), bfhi(aw.y), bflo(aw.z), bfhi(aw.z), bflo(aw.w), bfhi(aw.w)};
            const float uu[8] = {bflo(uw.x), bfhi(uw.x), bflo(uw.y), bfhi(uw.y), bflo(uw.z), bfhi(uw.z), bflo(uw.w), bfhi(uw.w)};
#pragma unroll
            for (int j = 0; j < 8; ++j) { Hh[j] = __expf(la[j]) * Hh[j] + uu[j]; Pp[j] += la[j]; }
        }
#pragma unroll
        for (int j = 0; j < 8; ++j) { sP[seg * 64 + cgp * 8 + j] = Pp[j]; sH[seg * 64 + cgp * 8 + j] = Hh[j]; }
        __syncthreads();
        if (F.tid < 64) {
            float car = 0.f;
            for (int s2 = 0; s2 < 64; ++s2) { const float pp = sP[s2 * 64 + F.tid], hh = sH[s2 * 64 + F.tid]; sH[s2 * 64 + F.tid] = car; car = __expf(pp) * car + hh; }
        }
        __syncthreads();
#pragma unroll
        for (int j = 0; j < 8; ++j) Hh[j] = sH[seg * 64 + cgp * 8 + j];
        int t = t_lo;
        for (; t < NMETA && t < t_hi; ++t) {
            const size_t off = (size_t)seq_row(b, t) * D + ch0;
            const u32x4 aw = *(const u32x4*)(LA + off), uw = *(const u32x4*)(LU + off);
            const float la[8] = {bflo(aw.x), bfhi(aw.x), bflo(aw.y), bfhi(aw.y), bflo(aw.z), bfhi(aw.z), bflo(aw.w), bfhi(aw.w)};
            const float uu[8] = {bflo(uw.x), bfhi(uw.x), bflo(uw.y), bfhi(uw.y), bflo(uw.z), bfhi(uw.z), bflo(uw.w), bfhi(uw.w)};
#pragma unroll
            for (int j = 0; j < 8; ++j) Hh[j] = __expf(la[j]) * Hh[j] + uu[j];
        }
#pragma unroll 4
        for (; t < t_hi; ++t) {
            const int row = b * SEQ + (t - NMETA);
            const size_t off = (size_t)row * D + ch0;
            const u32x4 aw = *(const u32x4*)(LA + off), uw = *(const u32x4*)(LU + off), gw = *(const u32x4*)(P + (size_t)row * NP + OLY + ch0);
            const float la[8] = {bflo(aw.x), bfhi(aw.x), bflo(aw.y), bfhi(aw.y), bflo(aw.z), bfhi(aw.z), bflo(aw.w), bfhi(aw.w)};
            const float uu[8] = {bflo(uw.x), bfhi(uw.x), bflo(uw.y), bfhi(uw.y), bflo(uw.z), bfhi(uw.z), bflo(uw.w), bfhi(uw.w)};
#pragma unroll
            for (int j = 0; j < 8; ++j) Hh[j] = __expf(la[j]) * Hh[j] + uu[j];
            u32x4 w; w.x = cvt_pk_bf16(Hh[0] * bflo(gw.x), Hh[1] * bfhi(gw.x)); w.y = cvt_pk_bf16(Hh[2] * bflo(gw.y), Hh[3] * bfhi(gw.y));
            w.z = cvt_pk_bf16(Hh[4] * bflo(gw.z), Hh[5] * bfhi(gw.z)); w.w = cvt_pk_bf16(Hh[6] * bflo(gw.w), Hh[7] * bfhi(gw.w));
            *(u32x4*)(YL + off) = w;
        }
        __syncthreads();
    }
}

__device__ void p7_router(const Frame& F) {
    const float* H1 = (const float*)(F.ws + WS_H1);
    bf16_t* U2 = (bf16_t*)(F.ws + WS_U2);
    const float* g = F.in[I_NORM_FFN];
    const bf16_t* WH = (const bf16_t*)(F.ws + WS_WRH); const bf16_t* WL = (const bf16_t*)(F.ws + WS_WRL);
    unsigned* cnt = (unsigned*)(F.ws + WS_CTL) + CW_CNT;
    int* list = (int*)(F.ws + WS_LIST); float* gate = (float*)(F.ws + WS_GATE);
    LAS float* rs = (LAS float*)F.lds;
    LAS float* part = rs + 64;
    LAS int* hc = (LAS int*)(F.lds + LDS_WORK - 1024);
    LAS int* hb = hc + 64;
    const int lane = F.lane, r = lane & 31, h = lane >> 5;
    LAS float* gl = (LAS float*)(F.lds + 104 * 1024);
    for (int i = F.tid; i < D / 4; i += NTHREADS) *(LAS f32x4*)(gl + 4 * i) = *(const f32x4*)(g + 4 * i);
    __syncthreads();
    for (int tile = F.vb; tile < T / 64; tile += F.G) {
        const int row0 = tile * 64;
        {
            constexpr int RSK = 272;
            LAS unsigned char* Lb = (LAS unsigned char*)part;
            LAS unsigned char* AH = Lb, *AL = AH + 64 * RSK, *BH = AL + 64 * RSK, *BL = BH + 96 * RSK;
            const int mt = F.wave & 1, ks = F.wave >> 1;
            const int arow = F.tid >> 3, aseg = F.tid & 7;
            float ssq = 0.f;
            bf16_t* udst = U2 + (size_t)(row0 + arow) * D + aseg * 16;
            const float* asrc = H1 + (size_t)(row0 + arow) * D + aseg * 16;
            const float* gsrc = g + aseg * 16;
            f32x16 acc[3];
#pragma unroll
            for (int nt = 0; nt < 3; ++nt)
#pragma unroll
                for (int j = 0; j < 16; ++j) acc[nt][j] = 0.f;
#define P7_LDA(c, RA) do { _Pragma("unroll") for (int i = 0; i < 4; ++i) RA[i] = *(const f32x4*)(asrc + (c) * 128 + 4 * i); } while (0)
#define P7_LDB(c) do { _Pragma("unroll") for (int i = 0; i < 3; ++i) { const int pc = F.tid + 512 * i, br = pc >> 4, bs = pc & 15; rbh[i] = *(const u32x4*)(WH + (size_t)br * D + (c) * 128 + bs * 8); rbl[i] = *(const u32x4*)(WL + (size_t)br * D + (c) * 128 + bs * 8); } } while (0)
#define P7_STEP(c, RA) do { \
                _Pragma("unroll") for (int i = 0; i < 2; ++i) { \
                    const f32x4 g0 = *(const LAS f32x4*)(gl + (c) * 128 + aseg * 16 + 8 * i), g1 = *(const LAS f32x4*)(gl + (c) * 128 + aseg * 16 + 8 * i + 4); \
                    float v[8]; \
                    _Pragma("unroll") for (int j = 0; j < 4; ++j) { v[j] = RA[2 * i][j] * g0[j]; v[4 + j] = RA[2 * i + 1][j] * g1[j]; ssq += RA[2 * i][j] * RA[2 * i][j] + RA[2 * i + 1][j] * RA[2 * i + 1][j]; } \
                    u32x4 hw, lw; \
                    hw.x = cvt_pk_bf16(v[0], v[1]); hw.y = cvt_pk_bf16(v[2], v[3]); hw.z = cvt_pk_bf16(v[4], v[5]); hw.w = cvt_pk_bf16(v[6], v[7]); \
                    lw.x = cvt_pk_bf16(v[0] - bflo(hw.x), v[1] - bfhi(hw.x)); lw.y = cvt_pk_bf16(v[2] - bflo(hw.y), v[3] - bfhi(hw.y)); \
                    lw.z = cvt_pk_bf16(v[4] - bflo(hw.z), v[5] - bfhi(hw.z)); lw.w = cvt_pk_bf16(v[6] - bflo(hw.w), v[7] - bfhi(hw.w)); \
                    *(LAS u32x4*)(AH + arow * RSK + aseg * 32 + i * 16) = hw; *(LAS u32x4*)(AL + arow * RSK + aseg * 32 + i * 16) = lw; \
                    *(u32x4*)(udst + (c) * 128 + i * 8) = hw;   \
                } \
                _Pragma("unroll") for (int i = 0; i < 3; ++i) { const int pc = F.tid + 512 * i, br = pc >> 4, bs = pc & 15; *(LAS u32x4*)(BH + br * RSK + bs * 16) = rbh[i]; *(LAS u32x4*)(BL + br * RSK + bs * 16) = rbl[i]; } \
                __syncthreads(); \
                if ((c) + 1 < 16) P7_LDB((c) + 1);      \
                if ((c) + 2 < 16) P7_LDA((c) + 2, RA);   \
                _Pragma("unroll") for (int kk = 0; kk < 2; ++kk) { \
                    const int ko = (ks * 2 + kk) * 32 + h * 16; \
                    const bf16x8 ah = *(const LAS bf16x8*)(AH + (mt * 32 + r) * RSK + ko), al = *(const LAS bf16x8*)(AL + (mt * 32 + r) * RSK + ko); \
                    _Pragma("unroll") for (int nt = 0; nt < 3; ++nt) { \
                        const bf16x8 bhv = *(const LAS bf16x8*)(BH + (nt * 32 + r) * RSK + ko), blv = *(const LAS bf16x8*)(BL + (nt * 32 + r) * RSK + ko); \
                        acc[nt] = __builtin_amdgcn_mfma_f32_32x32x16_bf16(ah, bhv, acc[nt], 0, 0, 0); \
                        acc[nt] = __builtin_amdgcn_mfma_f32_32x32x16_bf16(al, bhv, acc[nt], 0, 0, 0); \
                        acc[nt] = __builtin_amdgcn_mfma_f32_32x32x16_bf16(ah, blv, acc[nt], 0, 0, 0); \
                    } \
                } \
                __syncthreads(); } while (0)
            f32x4 ra0[4], ra1[4]; u32x4 rbh[3], rbl[3];
            P7_LDA(0, ra0); P7_LDB(0); P7_LDA(1, ra1);
#pragma unroll 1
            for (int c = 0; c < 16; c += 2) { P7_STEP(c, ra0); P7_STEP(c + 1, ra1); }
#undef P7_LDA
#undef P7_LDB
#undef P7_STEP
#pragma unroll
            for (int nt = 0; nt < 3; ++nt)
#pragma unroll
                for (int j = 0; j < 16; ++j) { const int tok = mt * 32 + (j & 3) + 8 * (j >> 2) + 4 * h; part[(ks * 64 + tok) * 97 + nt * 32 + r] = acc[nt][j]; }
            ssq += __shfl_xor(ssq, 1); ssq += __shfl_xor(ssq, 2); ssq += __shfl_xor(ssq, 4);
            if (aseg == 0) { const float rstd = rsqrtf(ssq * (1.0f / D) + EPS); rs[arow] = rstd; ((float*)(F.ws + WS_RSTD))[row0 + arow] = rstd; }
        }
        __syncthreads();
        if (F.tid < 64) {
            const LAS float* p0 = part + F.tid * 97;
            const float rsv = rs[F.tid];
            float l[8];
#pragma unroll
            for (int j = 0; j < 8; ++j) l[j] = rsv * ((p0[j] + p0[64 * 97 + j]) + (p0[128 * 97 + j] + p0[192 * 97 + j]));
            int gi = 0; float gm = l[0];
#pragma unroll
            for (int j = 1; j < 8; ++j) if (l[j] > gm) { gm = l[j]; gi = j; }
            float gs = 0.f;
#pragma unroll
            for (int j = 0; j < 8; ++j) gs += __expf(l[j] - gm);
            const float gp = 1.0f / gs;
            float el[8];
#pragma unroll
            for (int j = 0; j < 8; ++j) { const int n = 8 + gi * 8 + j; el[j] = rsv * ((p0[n] + p0[64 * 97 + n]) + (p0[128 * 97 + n] + p0[192 * 97 + n])); }
            int i0 = 0; float m0 = el[0];
#pragma unroll
            for (int j = 1; j < 8; ++j) if (el[j] > m0) { m0 = el[j]; i0 = j; }
            int i1 = -1; float m1 = -3.0e38f;
#pragma unroll
            for (int j = 0; j < 8; ++j) if (j != i0 && el[j] > m1) { m1 = el[j]; i1 = j; }
            const float r1 = __expf(m1 - m0), w0 = 1.0f / (1.0f + r1), w1 = r1 * w0;
            const int tokg = row0 + F.tid;
            const int e0 = gi * 8 + i0, e1 = gi * 8 + i1;
            gate[tokg * 2] = gp * w0; gate[tokg * 2 + 1] = gp * w1;
            hc[F.tid] = 0;
            asm volatile("s_waitcnt lgkmcnt(0)" ::: "memory");
            const int lk0 = __hip_atomic_fetch_add(hc + e0, 1, __ATOMIC_RELAXED, __HIP_MEMORY_SCOPE_WORKGROUP);
            const int lk1 = __hip_atomic_fetch_add(hc + e1, 1, __ATOMIC_RELAXED, __HIP_MEMORY_SCOPE_WORKGROUP);
            asm volatile("s_waitcnt lgkmcnt(0)" ::: "memory");
            const int mine = hc[F.tid];
            unsigned basee = 0u;
            if (mine > 0) basee = atomicAdd(&cnt[F.tid], (unsigned)mine);
            hb[F.tid] = (int)basee;
            asm volatile("s_waitcnt lgkmcnt(0)" ::: "memory");
            list[(size_t)e0 * T + hb[e0] + lk0] = tokg * 2; list[(size_t)e1 * T + hb[e1] + lk1] = tokg * 2 + 1;
        }
        __syncthreads();
    }
}

__device__ void moe_tables(const Frame& F, int nN, LAS int* ub, LAS int* tb, LAS int* cl) {
    const unsigned* cnt = (const unsigned*)(F.ws + WS_CTL) + CW_CNT;
    LAS int* us = cl + 80;
    if (F.tid < 64) {
        const int ce = (int)cnt[F.tid]; cl[F.tid] = ce;
        const int mt = (ce + 255) >> 8;
        const int ns = (mt > 0 && ce - ((mt - 1) << 8) <= 128) ? 1 : 0, nl = mt - ns;
        int incl = mt, incL = nl, incS = ns;
#pragma unroll
        for (int o = 1; o < 64; o <<= 1) { const int v = __shfl_up(incl, o), vL = __shfl_up(incL, o), vS = __shfl_up(incS, o); if (F.lane >= o) { incl += v; incL += vL; incS += vS; } }
        tb[F.tid] = incl - mt; ub[F.tid] = (incL - nl) * nN; us[F.tid] = (incS - ns) * nN;
        if (F.tid == 63) { tb[NEXP] = incl; ub[NEXP] = incL * nN; us[NEXP] = incS * nN; }
    }
    __syncthreads();
}

__device__ void p10_final(const Frame& F) {
    const float* H1 = (const float*)(F.ws + WS_H1);
    const bf16_t* Y = (const bf16_t*)(F.ws + WS_Y);
    const float* g = F.in[I_NORM_FINAL];
    for (int row = F.vb * 8 + F.wave; row < T; row += F.G * 8) {
        f32x4 v[8]; float ss = 0.f;
#pragma unroll
        for (int i = 0; i < 8; ++i) {
            const int col = i * 256 + F.lane * 4;
            v[i] = *(const f32x4*)(H1 + (size_t)row * D + col);
            const u32x2 a = *(const u32x2*)(Y + (size_t)(row * 2) * D + col), b = *(const u32x2*)(Y + (size_t)(row * 2 + 1) * D + col);
            v[i][0] += bflo(a.x) + bflo(b.x); v[i][1] += bfhi(a.x) + bfhi(b.x); v[i][2] += bflo(a.y) + bflo(b.y); v[i][3] += bfhi(a.y) + bfhi(b.y);
            ss += v[i][0] * v[i][0] + v[i][1] * v[i][1] + v[i][2] * v[i][2] + v[i][3] * v[i][3];
        }
        ss = wave_sum(ss);
        const float rstd = rsqrtf(ss * (1.0f / D) + EPS);
#pragma unroll
        for (int i = 0; i < 8; ++i) {
            const int col = i * 256 + F.lane * 4;
            const f32x4 gg = *(const f32x4*)(g + col);
            f32x4 o; o[0] = v[i][0] * rstd * gg[0]; o[1] = v[i][1] * rstd * gg[1]; o[2] = v[i][2] * rstd * gg[2]; o[3] = v[i][3] * rstd * gg[3];
            *(f32x4*)(F.out + (size_t)row * D + col) = o;
        }
    }
}


typedef __attribute__((address_space(4))) const Args* KArgsPtr;
__device__ __forceinline__ Frame refresh(const Frame& F0) {
    Frame F = F0;
    int t = threadIdx.x; asm volatile("" : "+v"(t));
    F.tid = t; F.lane = t & 63; F.wave = __builtin_amdgcn_readfirstlane(t >> 6);
    KArgsPtr ap = (KArgsPtr)__builtin_amdgcn_kernarg_segment_ptr(); asm volatile("" : "+s"(ap));
#pragma unroll
    for (int i = 0; i < 28; ++i) F.in[i] = ap->in[i];
    F.out = ap->out; F.ws = ap->ws;
    return F;
}
__device__ __forceinline__ void ph1(const Frame& F) {
    pg8::DenseSched S; S.init(F.ws + WS_U, D * 2, F.ws + WS_WIN, D, T / 256, NP / 256, F.G, F.vb);
    EpiProj E{(bf16_t*)(F.ws + WS_PROJ), F.in[I_GATE_BIAS]};
    pg8::gemm_phase<EpiProj, pg8::DenseSched, false>(F.lds, D, S, E);
    p1_thin(F);
}
__device__ __forceinline__ void ph3(const Frame& F) {
    p2_ssd_chunk(F);
    pg8::DenseSched S; S.init(F.ws + WS_XR, D * 2, F.ws + WS_WLRU, 256, 64, 16, F.G, F.vb, 512);
    EpiLru E{(const bf16_t*)(F.ws + WS_XR), (bf16_t*)(F.ws + WS_LOGA), (bf16_t*)(F.ws + WS_LU), F.in[I_LRU_BA], F.in[I_LRU_BX], F.in[I_LRU_LAMBDA]};
    pg8::gemm_phase<EpiLru, pg8::DenseSched, false>(F.lds, 256, S, E);
    p3_lru_meta(F);
}
__device__ __forceinline__ void ph4(const Frame& F) { p4_lru_scan(F); p3_ssd_norm(F); }
__device__ __forceinline__ void ph5(const Frame& F) {
    pg8::PairSched S; S.init(F.ws + WS_YSSDN, F.ws + WS_YLRU, D * 2, F.ws + WS_WSO, F.ws + WS_WLO, D, T / 256, D / 256, F.G, F.vb);
    EpiMixPair E{(const bf16_t*)(F.ws + WS_PROJ), (bf16_t*)(F.ws + WS_MIXED)};
    pg8::gemm_phase<EpiMixPair, pg8::PairSched, false, false, true>(F.lds, D, S, E);
}
__device__ __forceinline__ void ph6(const Frame& F) {
    pg8::DenseSched S; S.init(F.ws + WS_MIXED, D * 2, F.ws + WS_WOUT, D, T / 256, D / 256, F.G, F.vb);
    EpiRes E{F.in[I_X], (float*)(F.ws + WS_H1)};
    pg8::gemm_phase<EpiRes, pg8::DenseSched, false>(F.lds, D, S, E);
}
__device__ __forceinline__ void ph8(const Frame& F) {
    LAS int* ub = (LAS int*)(F.lds + MISC_OFF + 256); LAS int* tb = ub + 80; LAS int* cl = tb + 80;
    moe_tables(F, FF / 128, ub, tb, cl);
    pg8::MoeSched S; S.A = (const char*)(F.ws + WS_U2); S.W0 = (const char*)F.in[I_W_EG]; S.W1 = (const char*)F.in[I_W_EU]; S.list = (const int*)(F.ws + WS_LIST); S.ub = ub; S.us = cl + 80; S.tb = tb; S.cl = cl;
    S.rowval = (const float*)(F.ws + WS_RSTD); S.valshift = 1; S.rowtbl = F.lds + MOE_ROWTBL_OFF;
    S.lda = D * 2; S.K = D; S.nN = FF / 128; S.G = F.G; S.c = F.vb; S.gather = 1; S.ldb = FF * 4; S.cpn = 128 * 4; S.bstride = (size_t)D * FF * 4;
    EpiMoe1 E{(bf16_t*)(F.ws + WS_HDN), F.lds + MOE_ROWTBL_OFF};
    pg8::gemm_phase<EpiMoe1, pg8::MoeSched, true, true, false, true, true>(F.lds, D, S, E);
}
__device__ __forceinline__ void ph9(const Frame& F) {
    LAS int* ub = (LAS int*)(F.lds + MISC_OFF + 256); LAS int* tb = ub + 80; LAS int* cl = tb + 80;
    static_assert(FF / 128 == D / 256, "the MoE down phase reuses the unit tables of the MoE up phase");
#if MK_N_LAUNCHES != 1
    moe_tables(F, D / 256, ub, tb, cl);
#endif
    pg8::MoeSched S; S.A = (const char*)(F.ws + WS_HDN); S.W0 = (const char*)(F.ws + WS_W2); S.W1 = S.W0; S.list = (const int*)(F.ws + WS_LIST); S.ub = ub; S.us = cl + 80; S.tb = tb; S.cl = cl;
    S.rowval = (const float*)(F.ws + WS_GATE); S.valshift = 0; S.rowtbl = F.lds + MOE_ROWTBL_OFF;
    S.lda = FF * 2; S.K = FF; S.nN = D / 256; S.G = F.G; S.c = F.vb; S.gather = 0; S.ldb = 0; S.cpn = 256 * FF * 2; S.bstride = (size_t)D * FF * 2;
    EpiMoe2 E{(bf16_t*)(F.ws + WS_Y), F.lds + MOE_ROWTBL_OFF};
    pg8::gemm_phase<EpiMoe2, pg8::MoeSched, false, false, false, true, true>(F.lds, FF, S, E);
}

constexpr int N_PHASES = 11;
__global__ void __launch_bounds__(NTHREADS, 2) fwd(Args args) {
    extern __shared__ __attribute__((aligned(16))) unsigned char lds_raw[];
    Frame F0;
    F0.lds = (LAS unsigned char*)lds_raw;
    F0.tid = threadIdx.x; F0.lane = F0.tid & 63; F0.wave = __builtin_amdgcn_readfirstlane(F0.tid >> 6);
    F0.G = gridDim.x; F0.vb = blockIdx.x;
#pragma unroll
    for (int i = 0; i < 28; ++i) F0.in[i] = args.in[i];
    F0.out = args.out; F0.ws = args.ws;
    volatile LAS unsigned* MISC = (volatile LAS unsigned*)(F0.lds + MISC_OFF);
    if (threadIdx.x < 4) MISC[threadIdx.x] = 0u;
    __syncthreads();
    const int lo = args.ph_lo, hi = args.ph_hi;
    XcdBarrier bar; bar.bar = (unsigned*)(args.ws + WS_CTL) + CW_BAR; bar.x = 0; bar.st = MISC;
    if (hi - lo > 1) bar = xcd_barrier_post((unsigned*)(args.ws + WS_CTL) + CW_BAR, MISC);
#ifndef PHMASK
#define PHMASK 0x7ff
#endif
#define IN(k) (((PHMASK >> (k)) & 1) && lo <= (k) && (k) < hi)
#define SEAM(k) do { if (IN(k) && IN((k) + 1)) xcd_barrier(bar); } while (0)
#ifndef REPMASK
#define REPMASK 0
#endif

#define RUN(k, call) do { if (IN(k)) { { const Frame F = refresh(F0); call; } if ((REPMASK >> (k)) & 1) { const Frame F = refresh(F0); call; } } } while (0)
    RUN(0, p0_prologue(F));
    SEAM(0);
    RUN(1, ph1(F));
    SEAM(1);
    RUN(2, p2_conv(F));
    SEAM(2);
    RUN(3, ph3(F));
    SEAM(3);
    RUN(4, ph4(F));
    SEAM(4);
    RUN(5, ph5(F));
    SEAM(5);
    RUN(6, ph6(F));
    SEAM(6);
    RUN(7, p7_router(F));
    SEAM(7);
    RUN(8, ph8(F));
    SEAM(8);
    RUN(9, ph9(F));
    SEAM(9);
    RUN(10, p10_final(F));
#undef IN
#undef SEAM
}

extern "C" void kernel_launch(void* const* d_in, const int* in_sizes, int n_in, void* d_out, int out_size, void* d_ws, size_t ws_size, hipStream_t stream) {
    static int grid = 0;
    if (grid == 0) {
        if (n_in != 28 || ws_size < WS_END) { fprintf(stderr, "kernel_launch: unexpected n_in %d / ws_size %zu (need %zu)\n", n_in, ws_size, (size_t)WS_END); grid = -1; return; }
        int dev = 0, cus = 0, per_cu = 0;
        if (hipGetDevice(&dev) != hipSuccess || hipDeviceGetAttribute(&cus, hipDeviceAttributeMultiprocessorCount, dev) != hipSuccess) { grid = -1; return; }
        if (hipFuncSetAttribute((const void*)fwd, hipFuncAttributeMaxDynamicSharedMemorySize, LDS_BYTES) != hipSuccess) { fprintf(stderr, "kernel_launch: hipFuncSetAttribute failed\n"); grid = -1; return; }
        if (hipOccupancyMaxActiveBlocksPerMultiprocessor(&per_cu, (const void*)fwd, NTHREADS, LDS_BYTES) != hipSuccess || per_cu < 1) { fprintf(stderr, "kernel_launch: occupancy query says %d\n", per_cu); }
        (void)hipGetLastError();
        grid = cus;
    }
    if (grid < 0) return;
    (void)hipMemsetAsync((char*)d_ws + WS_CTL, 0, CTL_BYTES, stream);
    Args a; memset(&a, 0, sizeof(a));
    for (int i = 0; i < 28; ++i) a.in[i] = (const float*)d_in[i];
    a.out = (float*)d_out; a.ws = (unsigned char*)d_ws;
#if MK_N_LAUNCHES == 1
    a.ph_lo = 0; a.ph_hi = N_PHASES;
    hipLaunchKernelGGL(fwd, dim3(grid), dim3(NTHREADS), LDS_BYTES, stream, a);
#else
    for (int p = 0; p < N_PHASES; ++p) { a.ph_lo = p; a.ph_hi = p + 1; hipLaunchKernelGGL(fwd, dim3(grid), dim3(NTHREADS), LDS_BYTES, stream, a); }
#endif
}
```
